# Optimizing an MI355X kernel written in HIP

```python
import math
import jax
import jax.numpy as jnp
from jax import lax
import numpy as np

D_MODEL = 1024
BATCH = 32
SEQ = 256
DEPTH = 1
DEC_BATCH = 4
DEC_SEQ = 1024
PAST_LEN = 256

GRID_W = 64
RET_HEADS = 4
RET_DK = D_MODEL // 8
RET_DV = D_MODEL // 8
RET_QK = RET_HEADS * RET_DK
RET_WIDTH = RET_HEADS * RET_DV
RET_CHUNK = 128
HY_WIDTH = D_MODEL // 2
HY_ORDER = 2
HY_EMB_BANDS = 16
HY_EMB = 1 + 2 * HY_EMB_BANDS
HY_FILTER_HIDDEN = 64
HY_FAST_DECAY = 0.3
HY_SLOW_DECAY = 1.5
HY_TARGET = 1e-2
SHORT_CONV = 3
D_FF = -(-8 * D_MODEL // (3 * 256)) * 256
N_IN = 2 * RET_QK + 2 * RET_WIDTH + 3 * HY_WIDTH + 2 * D_MODEL
N_MOD = 6
EPS = 1e-6

kernel_name = 'retention_hyena_flow_step'


def rmsnorm(x, g):
    x32 = x.astype(jnp.float32)
    y = x32 * lax.rsqrt(jnp.mean(x32 * x32, axis=-1, keepdims=True) + EPS)
    return (y * g.astype(jnp.float32)).astype(x.dtype)


def ada_mod(cond, w, b):
    m = jax.nn.silu(cond) @ w + b
    return jnp.split(m[..., None, :], N_MOD, axis=-1)


def retention_chunkwise(q, k, v, gamma, s0):
    B, H, L, _ = q.shape
    n = L // RET_CHUNK

    def chunks(t):
        return jnp.moveaxis(t.reshape(B, H, n, RET_CHUNK, t.shape[-1]), 2, 0)

    log_g = jnp.log(gamma)
    pos = jnp.arange(RET_CHUNK, dtype=jnp.float32)
    rel = pos[:, None] - pos[None, :]
    lower = rel >= 0
    dmat = jnp.where(lower[None], jnp.exp(jnp.where(lower, rel, 0.0)[None] * log_g[:, None, None]), 0.0)
    q_decay = jnp.exp((pos + 1.0)[None] * log_g[:, None])
    k_decay = jnp.exp((RET_CHUNK - 1.0 - pos)[None] * log_g[:, None])
    chunk_decay = jnp.exp(RET_CHUNK * log_g)

    def step(s, qkv):
        qc, kc, vc = qkv
        att = jnp.einsum('bhid,bhjd->bhij', qc, kc) * dmat
        o = (jnp.einsum('bhij,bhjv->bhiv', att, vc)
             + jnp.einsum('bhid,bhdv->bhiv', qc, s) * q_decay[None, :, :, None])
        s = (s * chunk_decay[None, :, None, None]
             + jnp.einsum('bhjd,bhjv->bhdv', kc * k_decay[None, :, :, None], vc))
        return s, o

    s_final, o = lax.scan(step, s0, (chunks(q), chunks(k), chunks(v)))
    o = jnp.moveaxis(o, 0, 2).reshape(B, H, L, v.shape[-1])
    return o, s_final


def bidir_retention(q, k, v, gamma_f, gamma_b, s0_f, s0_b):
    o_f, s_f = retention_chunkwise(q, k, v, gamma_f, s0_f)
    o_b, s_b = retention_chunkwise(jnp.flip(q, 2), jnp.flip(k, 2), jnp.flip(v, 2), gamma_b, s0_b)
    return o_f + jnp.flip(o_b, 2), s_f, s_b


def head_groupnorm(o):
    mu = jnp.mean(o, axis=-1, keepdims=True)
    var = jnp.mean(jnp.square(o - mu), axis=-1, keepdims=True)
    return (o - mu) * lax.rsqrt(var + EPS)


def short_conv3(u, w, b, grid_w):
    B, L, C = u.shape
    if grid_w is not None:
        rows = L // grid_w
        u = u.reshape(B, rows, grid_w, C)
    pad = [(0, 0)] * (u.ndim - 2) + [(1, 1), (0, 0)]
    up = jnp.pad(u, pad)
    n = u.shape[-2]
    y = up[..., 0:n, :] * w[0] + up[..., 1:n + 1, :] * w[1] + up[..., 2:n + 2, :] * w[2] + b
    return y.reshape(B, L, C)


def hyena_filters(L, w1, b1, w2, b2, w3, freq):
    t = jnp.linspace(0.0, 1.0, L, dtype=jnp.float32)[:, None]
    ang = 2.0 * math.pi * jnp.arange(L, dtype=jnp.float32)[:, None] / L
    bands = jnp.linspace(1e-4, HY_EMB_BANDS - 1, HY_EMB_BANDS, dtype=jnp.float32)[None]
    z = jnp.concatenate([t, jnp.cos(bands * ang), -jnp.sin(bands * ang)], axis=-1)
    h = jnp.sin(freq * (z @ w1 + b1))
    h = jnp.sin(freq * (h @ w2 + b2))
    h = (h @ w3).reshape(L, HY_ORDER, 2, HY_WIDTH)
    max_decay = math.log(HY_TARGET) / HY_FAST_DECAY
    min_decay = math.log(HY_TARGET) / HY_SLOW_DECAY
    deltas = jnp.linspace(min_decay, max_decay, HY_WIDTH, dtype=jnp.float32)
    window = jnp.exp(-t * jnp.abs(deltas))
    h = h * window[:, None, None, :]
    fwd = h[:, :, 0]
    bwd = h[:, :, 1]
    k = jnp.concatenate([fwd, jnp.zeros_like(fwd[:1]), jnp.flip(bwd[1:], axis=0)], axis=0)
    k = k / jnp.sum(jnp.abs(k), axis=0, keepdims=True)
    return jnp.moveaxis(k, 1, 0)


def long_conv(u, k, bias):
    L = u.shape[1]
    uf = jnp.fft.rfft(u, n=2 * L, axis=1)
    kf = jnp.fft.rfft(k, n=2 * L, axis=0)
    y = jnp.fft.irfft(uf * kf[None], n=2 * L, axis=1)[:, :L]
    return y + u * bias


def trunk_layer(x, shift1, scale1, gate1, shift2, scale2, gate2, s0_fwd, s0_bwd, grid_w,
                norm1, norm2, w_in, decay_fwd, decay_bwd, conv_w, conv_b,
                pos_w1, pos_b1, pos_w2, pos_b2, pos_w3, sin_freq, hy_bias,
                w_ret_o, w_hy_o, w_out, w_ffn_in, w_ffn_out):
    B, L, _ = x.shape
    f32 = jnp.float32
    h = rmsnorm(x, norm1) * (1 + scale1) + shift1
    proj = h @ w_in
    splits = list(np.cumsum([RET_QK, RET_QK, RET_WIDTH, RET_WIDTH, 3 * HY_WIDTH, D_MODEL]))
    q, k, v, g, hu, g_ret, g_hy = jnp.split(proj, splits, axis=-1)

    def heads(t, d):
        return t.reshape(B, L, RET_HEADS, d).transpose(0, 2, 1, 3).astype(f32)
    qh = heads(q, RET_DK)
    kh = heads(k, RET_DK) * (RET_DK ** -0.5)
    vh = heads(v, RET_DV)
    gamma_f = jax.nn.sigmoid(decay_fwd.astype(f32))
    gamma_b = jax.nn.sigmoid(decay_bwd.astype(f32))
    o, s_f, s_b = bidir_retention(qh, kh, vh, gamma_f, gamma_b, s0_fwd.astype(f32), s0_bwd.astype(f32))
    o = head_groupnorm(o).transpose(0, 2, 1, 3).reshape(B, L, RET_WIDTH).astype(x.dtype)
    y_ret = (jax.nn.silu(g) * o) @ w_ret_o

    u = short_conv3(hu, conv_w, conv_b, grid_w).astype(f32)
    hv, hx1, hx2 = jnp.split(u, 3, axis=-1)
    kers = hyena_filters(L, pos_w1.astype(f32), pos_b1.astype(f32), pos_w2.astype(f32),
                         pos_b2.astype(f32), pos_w3.astype(f32), sin_freq.astype(f32))
    hb = hy_bias.astype(f32)
    z = hx1 * long_conv(hv, kers[0], hb[0])
    z = hx2 * long_conv(z, kers[1], hb[1])
    y_hy = z.astype(x.dtype) @ w_hy_o

    mix = jax.nn.sigmoid(g_ret) * y_ret + jax.nn.sigmoid(g_hy) * y_hy
    x = x + gate1 * (mix @ w_out)

    h2 = rmsnorm(x, norm2) * (1 + scale2) + shift2
    a, bgt = jnp.split(h2 @ w_ffn_in, 2, axis=-1)
    x = x + gate2 * ((jax.nn.silu(a) * bgt) @ w_ffn_out)
    return x, s_f, s_b


def setup_inputs(seed: int = 0) -> dict:
    key = jax.random.key(seed)
    ks = jax.random.split(key, 32)
    f32 = jnp.float32

    def nrm(k, shape, scale):
        return jax.random.normal(k, shape, f32) * scale

    st_shape = (DEC_BATCH, DEPTH, RET_HEADS, RET_DK, RET_DV)
    decay_init = jnp.log(2.0 ** (5.0 + jnp.arange(RET_HEADS, dtype=f32)) - 1.0)
    return {
        'x_prompt': nrm(ks[0], (BATCH, SEQ, D_MODEL), 1.0),
        'x_sample': nrm(ks[1], (DEC_BATCH, DEC_SEQ, D_MODEL), 1.0),
        'state_ret_fwd': nrm(ks[2], st_shape, 0.5),
        'state_ret_bwd': nrm(ks[3], st_shape, 0.5),
        'c': nrm(ks[4], (DEC_BATCH, D_MODEL), 1.0),
        'c_ctx': nrm(ks[5], (D_MODEL,), 1.0),
        'norm1_g': 1.0 + nrm(ks[6], (DEPTH, D_MODEL), 0.02),
        'norm2_g': 1.0 + nrm(ks[7], (DEPTH, D_MODEL), 0.02),
        'w_ada': nrm(ks[8], (DEPTH, D_MODEL, N_MOD * D_MODEL), 0.3 * D_MODEL ** -0.5),
        'b_ada': nrm(ks[9], (DEPTH, N_MOD * D_MODEL), 0.02),
        'w_in': nrm(ks[10], (DEPTH, D_MODEL, N_IN), D_MODEL ** -0.5),
        'ret_decay_fwd': decay_init[None] + nrm(ks[11], (DEPTH, RET_HEADS), 0.1),
        'ret_decay_bwd': decay_init[None] + nrm(ks[12], (DEPTH, RET_HEADS), 0.1),
        'hy_conv_w': nrm(ks[13], (DEPTH, SHORT_CONV, 3 * HY_WIDTH), SHORT_CONV ** -0.5),
        'hy_conv_b': nrm(ks[14], (DEPTH, 3 * HY_WIDTH), 0.02),
        'hy_pos_w1': nrm(ks[15], (DEPTH, HY_EMB, HY_FILTER_HIDDEN), HY_EMB ** -0.5),
        'hy_pos_b1': nrm(ks[16], (DEPTH, HY_FILTER_HIDDEN), 0.1),
        'hy_pos_w2': nrm(ks[17], (DEPTH, HY_FILTER_HIDDEN, HY_FILTER_HIDDEN), HY_FILTER_HIDDEN ** -0.5),
        'hy_pos_b2': nrm(ks[18], (DEPTH, HY_FILTER_HIDDEN), 0.1),
        'hy_pos_w3': nrm(ks[19], (DEPTH, HY_FILTER_HIDDEN, HY_ORDER * 2 * HY_WIDTH), HY_FILTER_HIDDEN ** -0.5),
        'hy_sin_freq': 1.0 + nrm(ks[20], (DEPTH, HY_FILTER_HIDDEN), 0.1),
        'hy_bias': nrm(ks[21], (DEPTH, HY_ORDER, HY_WIDTH), 0.1),
        'w_ret_o': nrm(ks[22], (DEPTH, RET_WIDTH, D_MODEL), RET_WIDTH ** -0.5),
        'w_hy_o': nrm(ks[23], (DEPTH, HY_WIDTH, D_MODEL), HY_WIDTH ** -0.5),
        'w_out': nrm(ks[24], (DEPTH, D_MODEL, D_MODEL), D_MODEL ** -0.5),
        'w_ffn_in': nrm(ks[25], (DEPTH, D_MODEL, 2 * D_FF), D_MODEL ** -0.5),
        'w_ffn_out': nrm(ks[26], (DEPTH, D_FF, D_MODEL), D_FF ** -0.5),
        'final_g': 1.0 + nrm(ks[27], (D_MODEL,), 0.02),
    }


def reference(x_prompt, x_sample, state_ret_fwd, state_ret_bwd, c, c_ctx,
              norm1_g, norm2_g, w_ada, b_ada, w_in, ret_decay_fwd, ret_decay_bwd,
              hy_conv_w, hy_conv_b, hy_pos_w1, hy_pos_b1, hy_pos_w2, hy_pos_b2, hy_pos_w3,
              hy_sin_freq, hy_bias, w_ret_o, w_hy_o, w_out, w_ffn_in, w_ffn_out, final_g):
    zero_state = jnp.zeros((x_prompt.shape[0], RET_HEADS, RET_DK, RET_DV), jnp.float32)
    xp = x_prompt
    new_f = []
    new_b = []
    for l in range(DEPTH):
        sh1, sc1, g1, sh2, sc2, g2 = ada_mod(c_ctx, w_ada[l], b_ada[l])
        xp, s_f, s_b = trunk_layer(
            xp, sh1, sc1, g1, sh2, sc2, g2, zero_state, zero_state, None,
            norm1_g[l], norm2_g[l], w_in[l], ret_decay_fwd[l], ret_decay_bwd[l],
            hy_conv_w[l], hy_conv_b[l], hy_pos_w1[l], hy_pos_b1[l], hy_pos_w2[l], hy_pos_b2[l],
            hy_pos_w3[l], hy_sin_freq[l], hy_bias[l], w_ret_o[l], w_hy_o[l], w_out[l],
            w_ffn_in[l], w_ffn_out[l])
        new_f.append(s_f)
        new_b.append(s_b)
    y_prompt = rmsnorm(xp, final_g)
    new_state_ret_fwd = jnp.stack(new_f, axis=1).astype(x_prompt.dtype)
    new_state_ret_bwd = jnp.stack(new_b, axis=1).astype(x_prompt.dtype)

    xs = x_sample
    for l in range(DEPTH):
        sh1, sc1, g1, sh2, sc2, g2 = ada_mod(c, w_ada[l], b_ada[l])
        xs, _, _ = trunk_layer(
            xs, sh1, sc1, g1, sh2, sc2, g2, state_ret_fwd[:, l], state_ret_bwd[:, l], GRID_W,
            norm1_g[l], norm2_g[l], w_in[l], ret_decay_fwd[l], ret_decay_bwd[l],
            hy_conv_w[l], hy_conv_b[l], hy_pos_w1[l], hy_pos_b1[l], hy_pos_w2[l], hy_pos_b2[l],
            hy_pos_w3[l], hy_sin_freq[l], hy_bias[l], w_ret_o[l], w_hy_o[l], w_out[l],
            w_ffn_in[l], w_ffn_out[l])
    y_sample = rmsnorm(xs, final_g)
    return (y_prompt, y_sample, new_state_ret_fwd, new_state_ret_bwd)
```

```cpp
#include <hip/hip_runtime.h>
#include <hip/hip_cooperative_groups.h>
#include <cstdio>
#include <cstdint>
namespace cg = cooperative_groups;
namespace pg8 {
#define PG8_LAS __attribute__((address_space(3)))
typedef unsigned short bf16_t;
typedef short bf16x8 __attribute__((ext_vector_type(8)));
typedef float f32x4 __attribute__((ext_vector_type(4)));
typedef unsigned u32x4 __attribute__((ext_vector_type(4)));
constexpr int BM = 256, BK = 64, HALF = 128, HTB = HALF * BK * 2  , STAGE_BYTES = 8 * HTB, NXCD = 8, WGM = 8;

__host__ __device__ __forceinline__ int lds_byte(int r, int c) { const int st = (r >> 4) * 2 + (c >> 5), rr = r & 15, cc = c & 31, ob = rr * 64 + cc * 2; return st * 1024 + (ob ^ (((ob >> 9) & 1) << 5)); }
__host__ __device__ __forceinline__ void stage_rc(int b, int& R, int& C) { const int st = b / 1024, sb = b % 1024, swz = sb ^ (((sb >> 9) & 1) << 5); R = (st >> 1) * 16 + swz / 64; C = (st & 1) * 32 + (swz % 64) / 2; }
__host__ __device__ __forceinline__ int perm32(int rho) { const int n = rho >> 4, i = rho & 15; return 8 * (i >> 2) + 4 * n + (i & 3); }

struct Unit { int pm, pn; };
struct Gemm { const bf16_t* A; const bf16_t* Bt; int M, N, K; };

struct StaticOrder {
    int nM, nN, nwg, G, c;
    __host__ __device__ void init(int M, int N, int G_, int c_) { nM = M / BM; nN = N / BM; nwg = nM * nN; G = G_; c = c_; }
    __host__ __device__ bool next(int i, Unit& u) const {
        const long L = (long)i * G + c; if (L >= nwg) return false;
        int wgid = (int)L; { const int q = nwg / NXCD, r = nwg % NXCD, xcd = wgid % NXCD, off = wgid / NXCD; wgid = (xcd < r ? xcd * (q + 1) : r * (q + 1) + (xcd - r) * q) + off; }
        const int nig = WGM * nN, gid = wgid / nig, fm = gid * WGM, gsz = (nM - fm) < WGM ? (nM - fm) : WGM;
        u.pm = fm + ((wgid % nig) % gsz); u.pn = (wgid % nig) / gsz; return true;
    }
    __device__ __forceinline__ void a_ready(const Unit&) const {}
    __device__ __forceinline__ void done(const Unit&) const {}
};
__device__ __forceinline__ unsigned cvt_pk_bf16(float lo, float hi) { unsigned r; asm volatile("v_cvt_pk_bf16_f32 %0, %1, %2" : "=v"(r) : "v"(lo), "v"(hi)); return r; }

template <class Epi, class Sched, bool STAMP = false>
__device__ __forceinline__ void gemm_phase(PG8_LAS unsigned char* lds, const Gemm g, const Sched& S, const Epi& E, unsigned long long* stamps) {
    const int tid = threadIdx.x, wid = __builtin_amdgcn_readfirstlane(tid >> 6), lane = tid & 63, wr = wid >> 2, wc = wid & 3, fr = lane & 15, fq = lane >> 4;
    const int K = g.K, nt = K / BK;
    int ts_lo = 0, ts_hi = 0, nts = 0; const unsigned long long rt_entry = STAMP ? (unsigned long long)wall_clock64() : 0ull;
#define PG8_STAMP() do { if (STAMP && wid == 0 && nts < 64) { const unsigned long long _c = (unsigned long long)clock64(); \
        ts_lo = (lane == nts) ? (int)(unsigned)_c : ts_lo; ts_hi = (lane == nts) ? (int)(unsigned)(_c >> 32) : ts_hi; ++nts; } } while (0)
    PG8_STAMP();
    unsigned voffA[2], voffB[2];
#pragma unroll
    for (int i = 0; i < 2; ++i) { int R, C; stage_rc(tid * 16 + i * 8192, R, C); const int Rb = Epi::PERM ? ((R & ~31) + perm32(R & 31)) : R;
        voffA[i] = (unsigned)(R * K + C) * 2u; voffB[i] = (unsigned)(Rb * K + C) * 2u; }
    const size_t kstep = (size_t)(BK * 2);
    const size_t hstep = (size_t)HALF * K * 2;
    const size_t tstep = 2 * hstep;
    const unsigned ldsw = (unsigned)wid * 1024u;
    const int aoff = lds_byte(wr * 64 + fr, fq * 8), boff = lds_byte(wc * 32 + fr, fq * 8);
#define PG8_SA(b, h) (((b) * 2 + (h)) * HTB)
#define PG8_SB(b, h) ((4 + (b) * 2 + (h)) * HTB)
#define PG8_STAGE(bufoff, gbase, voff) do { _Pragma("unroll") for (int _i = 0; _i < 2; ++_i) \
        __builtin_amdgcn_global_load_lds((const unsigned*)((const char*)(gbase) + (voff)[_i]), (PG8_LAS unsigned*)(lds + (bufoff) + ldsw + _i * 8192), 16, 0, 0); } while (0)
#define PG8_LDA(dst, b, h) do { _Pragma("unroll") for (int m = 0; m < 4; ++m) _Pragma("unroll") for (int k = 0; k < 2; ++k) dst[m][k] = *(const PG8_LAS bf16x8*)(lds + PG8_SA(b, h) + aoff + m * 2048 + k * 1024); } while (0)
#define PG8_LDB(dst, b, h) do { _Pragma("unroll") for (int n = 0; n < 2; ++n) _Pragma("unroll") for (int k = 0; k < 2; ++k) dst[n][k] = *(const PG8_LAS bf16x8*)(lds + PG8_SB(b, h) + boff + n * 2048 + k * 1024); } while (0)
#define PG8_MMA(ai, bj, At, Bt) do { __builtin_amdgcn_s_setprio(1); _Pragma("unroll") for (int m = 0; m < 4; ++m) _Pragma("unroll") for (int n = 0; n < 2; ++n) _Pragma("unroll") for (int k = 0; k < 2; ++k) \
        acc[ai][bj][m][n] = __builtin_amdgcn_mfma_f32_16x16x32_bf16(Bt[n][k], At[m][k], acc[ai][bj][m][n], 0, 0, 0); __builtin_amdgcn_s_setprio(0); } while (0)
#define PG8_WAIT_V(n) asm volatile("s_waitcnt vmcnt(" #n ")" ::: "memory")
#define PG8_WAIT_L(n) asm volatile("s_waitcnt lgkmcnt(" #n ")" ::: "memory")
#define PG8_BAR __builtin_amdgcn_s_barrier()
#define PG8_SCHED __builtin_amdgcn_sched_barrier(0)
    Unit cur, nxt; int ui = 0;
    if (!S.next(0, cur)) return;
    f32x4 acc[2][2][4][2];
#pragma unroll
    for (int a = 0; a < 2; ++a)
#pragma unroll
        for (int b = 0; b < 2; ++b)
#pragma unroll
            for (int m = 0; m < 4; ++m)
#pragma unroll
                for (int n = 0; n < 2; ++n) acc[a][b][m][n] = (f32x4){0.f, 0.f, 0.f, 0.f};
    bf16x8 At[4][2], B0[2][2], B1[2][2];
    const char* cA = (const char*)g.A + (size_t)cur.pm * tstep; const char* cB = (const char*)g.Bt + (size_t)cur.pn * tstep;
    S.a_ready(cur);
    PG8_STAGE(PG8_SB(0, 0), cB, voffB); PG8_STAGE(PG8_SA(0, 0), cA, voffA); PG8_STAGE(PG8_SB(0, 1), cB + hstep, voffB); PG8_STAGE(PG8_SA(0, 1), cA + hstep, voffA);
    if (wr == 1) PG8_BAR;
    PG8_WAIT_V(4); PG8_BAR;
    PG8_STAGE(PG8_SB(1, 0), cB + kstep, voffB); PG8_STAGE(PG8_SA(1, 0), cA + kstep, voffA); PG8_STAGE(PG8_SB(1, 1), cB + hstep + kstep, voffB);
    PG8_WAIT_V(6); PG8_BAR;
    PG8_STAMP();
    for (;;) {
        const bool has_next = S.next(ui + 1, nxt);
        const char* nA = has_next ? (const char*)g.A + (size_t)nxt.pm * tstep : cA; const char* nB = has_next ? (const char*)g.Bt + (size_t)nxt.pn * tstep : cB;
        for (int t = 0; t < nt; t += 2) {
            const bool last = (t == nt - 2);
            const char* a1 = cA + (size_t)(t + 1) * kstep;
            const char* a2 = last ? nA : cA + (size_t)(t + 2) * kstep; const char* b2 = last ? nB : cB + (size_t)(t + 2) * kstep;
            const char* a3 = a2 + kstep; const char* b3 = b2 + kstep;
            if (last && has_next) S.a_ready(nxt);
            PG8_LDB(B0, 0, 0); PG8_SCHED; PG8_LDA(At, 0, 0); PG8_STAGE(PG8_SA(1, 1), a1 + hstep, voffA);
            PG8_WAIT_L(8); PG8_BAR; PG8_WAIT_L(0); PG8_MMA(0, 0, At, B0); PG8_BAR; PG8_SCHED;
            PG8_LDB(B1, 0, 1); PG8_STAGE(PG8_SB(0, 0), b2, voffB);
            PG8_BAR; PG8_WAIT_L(0); PG8_MMA(0, 1, At, B1); PG8_BAR;
            PG8_LDA(At, 0, 1); PG8_STAGE(PG8_SA(0, 0), a2, voffA);
            PG8_BAR; PG8_WAIT_L(0); PG8_MMA(1, 0, At, B0); PG8_BAR; PG8_SCHED;
            PG8_STAGE(PG8_SB(0, 1), b2 + hstep, voffB);
            PG8_WAIT_V(6); PG8_BAR; PG8_MMA(1, 1, At, B1); PG8_BAR;
            PG8_LDB(B0, 1, 0); PG8_SCHED; PG8_LDA(At, 1, 0); PG8_STAGE(PG8_SA(0, 1), a2 + hstep, voffA);
            PG8_WAIT_L(8); PG8_BAR; PG8_WAIT_L(0); PG8_MMA(0, 0, At, B0); PG8_BAR; PG8_SCHED;
            PG8_LDB(B1, 1, 1); PG8_STAGE(PG8_SB(1, 0), b3, voffB);
            PG8_BAR; PG8_WAIT_L(0); PG8_MMA(0, 1, At, B1); PG8_BAR;
            PG8_LDA(At, 1, 1); PG8_STAGE(PG8_SA(1, 0), a3, voffA);
            PG8_BAR; PG8_WAIT_L(0); PG8_MMA(1, 0, At, B0); PG8_BAR; PG8_SCHED;
            PG8_STAGE(PG8_SB(1, 1), b3 + hstep, voffB);
            PG8_WAIT_V(6); PG8_BAR; PG8_MMA(1, 1, At, B1); PG8_BAR;
        }
        PG8_STAMP();
        if constexpr (!Epi::AFTER_DRAIN) { E(acc, cur, wr, wc, fr, fq); S.done(cur); }
        PG8_STAMP();
        if (!has_next) break;
#pragma unroll
        for (int a = 0; a < 2; ++a)
#pragma unroll
            for (int b = 0; b < 2; ++b)
#pragma unroll
                for (int m = 0; m < 4; ++m)
#pragma unroll
                    for (int n = 0; n < 2; ++n) acc[a][b][m][n] = (f32x4){0.f, 0.f, 0.f, 0.f};
        cur = nxt; cA = nA; cB = nB; ++ui;
    }
    PG8_WAIT_V(0);
    if (wr == 0) PG8_BAR;
    PG8_BAR;
    if constexpr (Epi::AFTER_DRAIN) { E.fused(acc, cur, wr, wc, fr, fq, lds, wid, lane); S.done(cur); }
    PG8_STAMP();
    if (STAMP && wid == 0) { stamps[lane] = lane < nts ? (((unsigned long long)(unsigned)ts_hi << 32) | (unsigned)ts_lo) : 0ull;
        if (lane == 62) stamps[62] = rt_entry; if (lane == 63) stamps[63] = (unsigned long long)wall_clock64(); }
#undef PG8_STAMP
#undef PG8_SA
#undef PG8_SB
#undef PG8_STAGE
#undef PG8_LDA
#undef PG8_LDB
#undef PG8_MMA
#undef PG8_WAIT_V
#undef PG8_WAIT_L
#undef PG8_BAR
#undef PG8_SCHED
}
}

using pg8::bf16_t; using pg8::bf16x8; using pg8::f32x4; using pg8::u32x4; using pg8::Unit; using pg8::cvt_pk_bf16;
typedef float f32x16 __attribute__((ext_vector_type(16)));
typedef unsigned u32x2 __attribute__((ext_vector_type(2)));

#ifndef MK_ONE_LAUNCH
#define MK_ONE_LAUNCH 0
#endif

constexpr int DM = 1024, NCTX = 8192, MTOK = 12288, NIN = 5632, DFF = 2816, PLD = 3584, SGLD = 2048, NMOD = 6144;
constexpr int N_PHASES = 10;
constexpr size_t MiB = 1u << 20;
constexpr size_t WS_MOD = 1 * MiB, WS_H2F = WS_MOD + 128 * 1024, WS_FPART = WS_MOD + 512 * 1024;
constexpr size_t WS_WIN = 3 * MiB, WS_WFI = 14 * MiB, WS_WFO = 25 * MiB, WS_WOUT = 31 * MiB, WS_WRET = 33 * MiB, WS_WHY = 34 * MiB;
constexpr size_t WS_FG256 = 35 * MiB, WS_FG1024 = 37 * MiB, WS_HB = 45 * MiB, WS_R = 69 * MiB, WS_Z = 81 * MiB, WS_SG = 93 * MiB, WS_P = 141 * MiB, WS_ACT = 141 * MiB, WS_END = 225 * MiB;
constexpr int LDS_BYTES = 147456;

struct Args { const float* in[28]; float* out; unsigned char* ws; int ph_lo, ph_hi; };

__device__ __forceinline__ float bf_lo(unsigned w) { return __uint_as_float(w << 16); }
__device__ __forceinline__ float bf_hi(unsigned w) { return __uint_as_float(w & 0xffff0000u); }
__device__ __forceinline__ float bf2f(bf16_t b) { return __uint_as_float(((unsigned)b) << 16); }
__device__ __forceinline__ bf16_t f2bf(float f) { return (bf16_t)(cvt_pk_bf16(f, 0.0f) & 0xffffu); }
__device__ __forceinline__ float wsum16(float v) { v += __shfl_xor(v, 1); v += __shfl_xor(v, 2); v += __shfl_xor(v, 4); v += __shfl_xor(v, 8); return v; }
__device__ __forceinline__ float wsum64(float v) { v = wsum16(v); v += __shfl_xor(v, 16); v += __shfl_xor(v, 32); return v; }
__device__ __forceinline__ float log2_sigmoid(float x) { return -log1pf(expf(-x)) * 1.4426950408889634f; }
__device__ __forceinline__ int row_group(int row) { return row < NCTX ? 0 : 1 + ((row - NCTX) >> 10); }

__device__ __forceinline__ float act_apply(float v, int mode) {
    if (mode == 0) return v;
    if (mode == 1) return v * 0.08838834764831845f;
    const float s = 1.0f / (1.0f + __expf(-v));
    return mode == 2 ? v * s : s;
}
struct EpiInProj {
    static constexpr bool PERM = true, AFTER_DRAIN = false;
    bf16_t* P; bf16_t* SG;
    __device__ __forceinline__ void operator()(const f32x4 (&acc)[2][2][4][2], const Unit& u, int wr, int wc, int fr, int fq) const {
        const int row0 = u.pm * 256 + wr * 64 + fr, pn = u.pn;
        bf16_t* base; int ldc, colt, mode;
        if (pn < 14) { base = P; ldc = PLD; colt = pn * 256; mode = (pn == 2 || pn == 3) ? 1 : ((pn == 6 || pn == 7) ? 2 : 0); }
        else { base = SG; ldc = SGLD; colt = pn * 256 - PLD; mode = 3; }
        const int col0 = colt + wc * 32 + 8 * fq;
#pragma unroll
        for (int ai = 0; ai < 2; ++ai)
#pragma unroll
            for (int m = 0; m < 4; ++m) { bf16_t* rowp = base + (size_t)(row0 + ai * 128 + m * 16) * ldc + col0;
#pragma unroll
                for (int bj = 0; bj < 2; ++bj) { const f32x4 v0 = acc[ai][bj][m][0], v1 = acc[ai][bj][m][1];
                    u32x4 w; w.x = cvt_pk_bf16(act_apply(v0[0], mode), act_apply(v0[1], mode)); w.y = cvt_pk_bf16(act_apply(v0[2], mode), act_apply(v0[3], mode));
                    w.z = cvt_pk_bf16(act_apply(v1[0], mode), act_apply(v1[1], mode)); w.w = cvt_pk_bf16(act_apply(v1[2], mode), act_apply(v1[3], mode));
                    *(u32x4*)(rowp + bj * 128) = w; } }
    }
};
struct EpiGateT1 {
    static constexpr bool PERM = false, AFTER_DRAIN = false;
    float* T1; const bf16_t* SG;
    __device__ __forceinline__ void operator()(const f32x4 (&acc)[2][2][4][2], const Unit& u, int wr, int wc, int fr, int fq) const {
        const int row0 = u.pm * 256 + wr * 64 + fr, col0 = u.pn * 256 + wc * 32 + 4 * fq;
#pragma unroll
        for (int ai = 0; ai < 2; ++ai)
#pragma unroll
            for (int m = 0; m < 4; ++m) { const int row = row0 + ai * 128 + m * 16;
#pragma unroll
                for (int bj = 0; bj < 2; ++bj)
#pragma unroll
                    for (int n = 0; n < 2; ++n) { const int col = col0 + bj * 128 + n * 16;
                        const u32x2 g = *(const u32x2*)(SG + (size_t)row * SGLD + col);
                        const f32x4 gv = {bf_lo(g.x), bf_hi(g.x), bf_lo(g.y), bf_hi(g.y)};
                        *(f32x4*)(T1 + (size_t)row * DM + col) = acc[ai][bj][m][n] * gv; }
                asm volatile("" ::: "memory"); }
    }
};
struct EpiMix {
    static constexpr bool PERM = false, AFTER_DRAIN = false;
    const float* T1; const bf16_t* SG; bf16_t* MIX;
    __device__ __forceinline__ void operator()(const f32x4 (&acc)[2][2][4][2], const Unit& u, int wr, int wc, int fr, int fq) const {
        const int row0 = u.pm * 256 + wr * 64 + fr, col0 = u.pn * 256 + wc * 32 + 4 * fq;
#pragma unroll
        for (int ai = 0; ai < 2; ++ai)
#pragma unroll
            for (int m = 0; m < 4; ++m) { const int row = row0 + ai * 128 + m * 16;
#pragma unroll
                for (int bj = 0; bj < 2; ++bj)
#pragma unroll
                    for (int n = 0; n < 2; ++n) { const int col = col0 + bj * 128 + n * 16;
                        const u32x2 g = *(const u32x2*)(SG + (size_t)row * SGLD + 1024 + col);
                        const f32x4 gv = {bf_lo(g.x), bf_hi(g.x), bf_lo(g.y), bf_hi(g.y)};
                        const f32x4 t = *(const f32x4*)(T1 + (size_t)row * DM + col);
                        const f32x4 r = t + acc[ai][bj][m][n] * gv;
                        u32x2 o; o.x = cvt_pk_bf16(r[0], r[1]); o.y = cvt_pk_bf16(r[2], r[3]);
                        *(u32x2*)(MIX + (size_t)row * DM + col) = o; }
                asm volatile("" ::: "memory"); }
    }
};
struct EpiRes {
    static constexpr bool PERM = false, AFTER_DRAIN = false;
    const float* b0; const float* b1;
    const float* gate;
    float* OUT;
    __device__ __forceinline__ void operator()(const f32x4 (&acc)[2][2][4][2], const Unit& u, int wr, int wc, int fr, int fq) const {
        const int row0 = u.pm * 256 + wr * 64 + fr, col0 = u.pn * 256 + wc * 32 + 4 * fq;
        const int grp = u.pm < 32 ? 0 : 1 + ((u.pm - 32) >> 2);
        const float* gp = gate + grp * NMOD + col0;
        f32x4 gv[2][2];
#pragma unroll
        for (int bj = 0; bj < 2; ++bj)
#pragma unroll
            for (int n = 0; n < 2; ++n) gv[bj][n] = *(const f32x4*)(gp + bj * 128 + n * 16);
#pragma unroll
        for (int ai = 0; ai < 2; ++ai)
#pragma unroll
            for (int m = 0; m < 4; ++m) { const int row = row0 + ai * 128 + m * 16;
                const float* bp = (u.pm < 32 ? b0 + (size_t)row * DM : b1 + (size_t)(row - NCTX) * DM) + col0;
                float* op = OUT + (size_t)row * DM + col0;
#pragma unroll
                for (int bj = 0; bj < 2; ++bj)
#pragma unroll
                    for (int n = 0; n < 2; ++n) { const f32x4 b = *(const f32x4*)(bp + bj * 128 + n * 16);
                        *(f32x4*)(op + bj * 128 + n * 16) = b + gv[bj][n] * acc[ai][bj][m][n]; } }
    }
};
struct EpiSwiglu {
    static constexpr bool PERM = true, AFTER_DRAIN = false;
    bf16_t* ACT;
    __device__ __forceinline__ void operator()(const f32x4 (&acc)[2][2][4][2], const Unit& u, int wr, int wc, int fr, int fq) const {
        const int row0 = u.pm * 256 + wr * 64 + fr, col0 = u.pn * 128 + wc * 32 + 8 * fq;
#pragma unroll
        for (int ai = 0; ai < 2; ++ai)
#pragma unroll
            for (int m = 0; m < 4; ++m) { bf16_t* rowp = ACT + (size_t)(row0 + ai * 128 + m * 16) * DFF + col0;
                float r[8];
#pragma unroll
                for (int n = 0; n < 2; ++n)
#pragma unroll
                    for (int j = 0; j < 4; ++j) { const float av = acc[ai][0][m][n][j], bv = acc[ai][1][m][n][j]; r[n * 4 + j] = av / (1.0f + __expf(-av)) * bv; }
                u32x4 w; w.x = cvt_pk_bf16(r[0], r[1]); w.y = cvt_pk_bf16(r[2], r[3]); w.z = cvt_pk_bf16(r[4], r[5]); w.w = cvt_pk_bf16(r[6], r[7]);
                *(u32x4*)rowp = w; }
    }
};

__device__ __forceinline__ void ph0_ada(const Args& a, int task, float* sm) {
    const int tid = threadIdx.x;
    float* sc = sm; float* red = sm + 5120;
    for (int i = tid; i < 5120; i += 512) { const int g = i >> 10, k = i & 1023; const float v = g == 0 ? a.in[5][k] : a.in[4][(g - 1) * 1024 + k]; sc[i] = v / (1.0f + expf(-v)); }
    __syncthreads();
    const int nl = tid & 31, kg = tid >> 5, n = task * 32 + nl;
    float a0 = 0.f, a1 = 0.f, a2 = 0.f, a3 = 0.f, a4 = 0.f;
    const float* w = a.in[8] + (size_t)(kg * 64) * NMOD + n;
#pragma unroll 8
    for (int k = 0; k < 64; ++k) { const float wv = w[(size_t)k * NMOD]; const int kk = kg * 64 + k;
        a0 += sc[kk] * wv; a1 += sc[1024 + kk] * wv; a2 += sc[2048 + kk] * wv; a3 += sc[3072 + kk] * wv; a4 += sc[4096 + kk] * wv; }
    red[(kg * 5 + 0) * 32 + nl] = a0; red[(kg * 5 + 1) * 32 + nl] = a1; red[(kg * 5 + 2) * 32 + nl] = a2; red[(kg * 5 + 3) * 32 + nl] = a3; red[(kg * 5 + 4) * 32 + nl] = a4;
    __syncthreads();
    if (tid < 160) { const int g = tid >> 5, l = tid & 31; float s = a.in[9][task * 32 + l];
        for (int q = 0; q < 16; ++q) s += red[(q * 5 + g) * 32 + l];
        ((float*)(a.ws + WS_MOD))[g * NMOD + task * 32 + l] = s; }
    __syncthreads();
}
__device__ __forceinline__ void ph0_hidden(const Args& a, int task, float* sm) {
    float* zf = sm; float* h1s = sm + 320;
    const int tid = threadIdx.x, rr = tid >> 6, j = tid & 63, r = task * 8 + rr;
    const int L = r < 256 ? 256 : 1024, t = r < 256 ? r : r - 256;
    if (j < 33) { float v;
        if (j == 0) v = (float)t / (float)(L - 1);
        else { const int b = (j - 1) & 15; const float band = 1e-4f + (float)b * ((15.0f - 1e-4f) / 15.0f); const float ang = 6.283185307179586f * (float)t / (float)L;
            v = j <= 16 ? cosf(band * ang) : -sinf(band * ang); }
        zf[rr * 40 + j] = v; }
    __syncthreads();
    const float fq = a.in[20][j];
    float s = a.in[16][j];
    for (int e = 0; e < 33; ++e) s += zf[rr * 40 + e] * a.in[15][e * 64 + j];
    h1s[rr * 64 + j] = sinf(fq * s);
    __syncthreads();
    float s2 = a.in[18][j];
    for (int k = 0; k < 64; ++k) s2 += h1s[rr * 64 + k] * a.in[17][k * 64 + j];
    ((float*)(a.ws + WS_H2F))[r * 64 + j] = sinf(fq * s2);
    __syncthreads();
}
__device__ __forceinline__ void ph0_wtile(const float* W, bf16_t* Wt, int K, int N, int kt, int nt, bool permffn, float* sm) {
    const int tid = threadIdx.x;
    { const int k = tid >> 3, n8 = (tid & 7) * 8; const float* src = W + (size_t)(kt * 64 + k) * N + nt * 64 + n8;
      const f32x4 v0 = *(const f32x4*)src, v1 = *(const f32x4*)(src + 4);
      float* d = sm + k * 65 + n8; d[0] = v0[0]; d[1] = v0[1]; d[2] = v0[2]; d[3] = v0[3]; d[4] = v1[0]; d[5] = v1[1]; d[6] = v1[2]; d[7] = v1[3]; }
    __syncthreads();
    { const int n = tid >> 3, k8 = (tid & 7) * 8; const float* s = sm + k8 * 65 + n;
      u32x4 w; w.x = cvt_pk_bf16(s[0], s[65]); w.y = cvt_pk_bf16(s[130], s[195]); w.z = cvt_pk_bf16(s[260], s[325]); w.w = cvt_pk_bf16(s[390], s[455]);
      int nn = nt * 64 + n;
      if (permffn) nn = nn < DFF ? ((nn >> 7) * 256 + (nn & 127)) : (((nn - DFF) >> 7) * 256 + 128 + ((nn - DFF) & 127));
      *(u32x4*)(Wt + (size_t)nn * K + kt * 64 + k8) = w; }
    __syncthreads();
}
__device__ __forceinline__ void ph1_taps(const Args& a, int task) {
    const int ch = task >> 2, cb = task & 3, col = cb * 512 + (int)threadIdx.x;
    const bool small = ch < 16; const int L = small ? 256 : 1024, t0 = small ? ch * 16 : (ch - 16) * 16, rowbase = small ? 0 : 256;
    float w3c[64];
#pragma unroll
    for (int k = 0; k < 64; ++k) w3c[k] = a.in[19][k * 2048 + col];
    const int o = col >> 10, dir = (col >> 9) & 1, cch = col & 511;
    const float dmin = -3.0701134573253945f, dmax = -15.350567286626973f;
    const float delta = fabsf(dmin + (float)cch * ((dmax - dmin) / 511.0f));
    float* fg = (float*)(a.ws + (small ? WS_FG256 : WS_FG1024)) + (size_t)(o * 512 + cch) * (2 * L);
    const float* h2 = (const float*)(a.ws + WS_H2F);
    float psum = 0.f;
#pragma unroll 1
    for (int tt = 0; tt < 16; ++tt) { const int t = t0 + tt; const float* hr = h2 + (size_t)(rowbase + t) * 64;
        float s = 0.f;
#pragma unroll
        for (int k = 0; k < 64; ++k) s += hr[k] * w3c[k];
        const float v = s * expf(-((float)t / (float)(L - 1)) * delta);
        if (dir == 0) { fg[L - 1 - t] = v; psum += fabsf(v); }
        else if (t >= 1) { fg[L - 1 + t] = v; psum += fabsf(v); } }
    if (dir == 1 && t0 == 0) fg[2 * L - 1] = 0.f;
    ((float*)(a.ws + WS_FPART))[ch * 2048 + col] = psum;
}
__device__ __forceinline__ void norm_mod_rows(const Args& a, const float* s0, const float* s1, const float* gw, int shoff, int scoff, bf16_t* dst) {
    const int lane = threadIdx.x & 63, w = threadIdx.x >> 6;
    const float* MOD = (const float*)(a.ws + WS_MOD);
    for (int row = blockIdx.x * 8 + w; row < MTOK; row += gridDim.x * 8) {
        const float* xr = row < NCTX ? s0 + (size_t)row * DM : s1 + (size_t)(row - NCTX) * DM;
        const float* mg = MOD + row_group(row) * NMOD;
        f32x4 v[4]; float ss = 0.f;
#pragma unroll
        for (int i = 0; i < 4; ++i) { v[i] = *(const f32x4*)(xr + i * 256 + lane * 4); ss += v[i][0] * v[i][0] + v[i][1] * v[i][1] + v[i][2] * v[i][2] + v[i][3] * v[i][3]; }
        ss = wsum64(ss);
        const float rstd = rsqrtf(ss * (1.0f / 1024.0f) + 1e-6f);
#pragma unroll
        for (int i = 0; i < 4; ++i) { const int c = i * 256 + lane * 4;
            const f32x4 g = *(const f32x4*)(gw + c), sc = *(const f32x4*)(mg + scoff + c), sh = *(const f32x4*)(mg + shoff + c);
            const f32x4 y = v[i] * rstd * g * (sc + 1.0f) + sh;
            u32x2 o; o.x = cvt_pk_bf16(y[0], y[1]); o.y = cvt_pk_bf16(y[2], y[3]);
            *(u32x2*)(dst + (size_t)row * DM + c) = o; }
    }
}
constexpr int RLD = 136, SLD = 264, ULD = 1032;
#define MFMA16(a_, b_, c_) __builtin_amdgcn_mfma_f32_16x16x32_bf16((a_), (b_), (c_), 0, 0, 0)
__device__ __forceinline__ void ret_unit(const Args& a, unsigned char* smem, int tokbase, int L, int bsel, int h, int qt) {
    bf16_t* Ks = (bf16_t*)smem; bf16_t* Vt = Ks + 128 * RLD; bf16_t* Ps = Vt + 128 * RLD;
    const bf16_t* P = (const bf16_t*)(a.ws + WS_P);
    const int tid = threadIdx.x, lane = tid & 63, w = tid >> 6, l15 = lane & 15, lq = lane >> 4;
    const float lgf = log2_sigmoid(a.in[11][h]), lgb = log2_sigmoid(a.in[12][h]);
    const int t0 = qt * 128;
    bf16x8 qf[4];
    { const bf16_t* qp = P + (size_t)(tokbase + t0 + 16 * w + l15) * PLD + h * 128 + 8 * lq;
#pragma unroll
      for (int ks = 0; ks < 4; ++ks) qf[ks] = *(const bf16x8*)(qp + 32 * ks); }
    f32x4 oacc[8];
#pragma unroll
    for (int nd = 0; nd < 8; ++nd) oacc[nd] = (f32x4){0.f, 0.f, 0.f, 0.f};
    bf16_t* Pw = Ps + w * 16 * RLD;
    const int nkt = L >> 7;
#pragma unroll 1
    for (int kt = 0; kt < nkt; ++kt) {
        __syncthreads();
#pragma unroll
        for (int i = 0; i < 4; ++i) { const int p = tid + 512 * i, key = p >> 4, d8 = (p & 15) * 8;
            const bf16_t* src = P + (size_t)(tokbase + kt * 128 + key) * PLD + 512 + h * 128 + d8;
            const u32x4 kv = *(const u32x4*)src; *(u32x4*)(Ks + key * RLD + d8) = kv;
            const u32x4 vv = *(const u32x4*)(src + 512);
            bf16_t* vd = Vt + d8 * RLD + key;
            vd[0] = (bf16_t)(vv.x & 0xffffu); vd[RLD] = (bf16_t)(vv.x >> 16); vd[2 * RLD] = (bf16_t)(vv.y & 0xffffu); vd[3 * RLD] = (bf16_t)(vv.y >> 16);
            vd[4 * RLD] = (bf16_t)(vv.z & 0xffffu); vd[5 * RLD] = (bf16_t)(vv.z >> 16); vd[6 * RLD] = (bf16_t)(vv.w & 0xffffu); vd[7 * RLD] = (bf16_t)(vv.w >> 16); }
        __syncthreads();
#pragma unroll
        for (int nt = 0; nt < 8; ++nt) { f32x4 s = (f32x4){0.f, 0.f, 0.f, 0.f};
#pragma unroll
            for (int ks = 0; ks < 4; ++ks) { const bf16x8 b = *(const bf16x8*)(Ks + (16 * nt + l15) * RLD + 32 * ks + 8 * lq); s = MFMA16(qf[ks], b, s); }
#pragma unroll
            for (int r = 0; r < 4; ++r) { const int tq = t0 + 16 * w + 4 * lq + r, jk = kt * 128 + 16 * nt + l15, d = tq - jk;
                const float f = d > 0 ? exp2f((float)d * lgf) : (d < 0 ? exp2f((float)(-d) * lgb) : 2.0f);
                Pw[(4 * lq + r) * RLD + 16 * nt + l15] = f2bf(s[r] * f); } }
        __syncthreads();
        bf16x8 pa[4];
#pragma unroll
        for (int ks = 0; ks < 4; ++ks) pa[ks] = *(const bf16x8*)(Pw + l15 * RLD + 32 * ks + 8 * lq);
#pragma unroll
        for (int nd = 0; nd < 8; ++nd)
#pragma unroll
            for (int ks = 0; ks < 4; ++ks) { const bf16x8 b = *(const bf16x8*)(Vt + (16 * nd + l15) * RLD + 32 * ks + 8 * lq); oacc[nd] = MFMA16(pa[ks], b, oacc[nd]); }
    }
    if (bsel >= 0) {
#pragma unroll 1
        for (int dir = 0; dir < 2; ++dir) {
            const float* S0 = a.in[2 + dir] + (size_t)(bsel * 4 + h) * 16384;
            __syncthreads();
#pragma unroll
            for (int i = 0; i < 8; ++i) { const int p = tid + 512 * i, dk = p >> 5, dv4 = (p & 31) * 4;
                const f32x4 v = *(const f32x4*)(S0 + dk * 128 + dv4);
                bf16_t* d = Vt + dv4 * RLD + dk; d[0] = f2bf(v[0]); d[RLD] = f2bf(v[1]); d[2 * RLD] = f2bf(v[2]); d[3 * RLD] = f2bf(v[3]); }
            __syncthreads();
            float fac[4];
#pragma unroll
            for (int r = 0; r < 4; ++r) { const int tq = t0 + 16 * w + 4 * lq + r; fac[r] = dir == 0 ? exp2f((float)(tq + 1) * lgf) : exp2f((float)(L - tq) * lgb); }
#pragma unroll
            for (int nd = 0; nd < 8; ++nd) { f32x4 t = (f32x4){0.f, 0.f, 0.f, 0.f};
#pragma unroll
                for (int ks = 0; ks < 4; ++ks) { const bf16x8 b = *(const bf16x8*)(Vt + (16 * nd + l15) * RLD + 32 * ks + 8 * lq); t = MFMA16(qf[ks], b, t); }
#pragma unroll
                for (int r = 0; r < 4; ++r) oacc[nd][r] += fac[r] * t[r]; }
        }
    }
    bf16_t* R = (bf16_t*)(a.ws + WS_R);
#pragma unroll
    for (int r = 0; r < 4; ++r) {
        float s = 0.f;
#pragma unroll
        for (int nd = 0; nd < 8; ++nd) s += oacc[nd][r];
        s = wsum16(s); const float mu = s * (1.0f / 128.0f);
        float q = 0.f;
#pragma unroll
        for (int nd = 0; nd < 8; ++nd) { const float dlt = oacc[nd][r] - mu; q += dlt * dlt; }
        q = wsum16(q); const float rs = rsqrtf(q * (1.0f / 128.0f) + 1e-6f);
        const size_t tok = (size_t)(tokbase + t0 + 16 * w + 4 * lq + r);
#pragma unroll
        for (int nd = 0; nd < 8; ++nd) { const int dv = 16 * nd + l15;
            const float gv = bf2f(P[tok * PLD + 1536 + h * 128 + dv]);
            R[tok * 512 + h * 128 + dv] = f2bf((oacc[nd][r] - mu) * rs * gv); }
    }
}
__device__ __forceinline__ void state_unit(const Args& a, unsigned char* smem, int b, int h, int dir) {
    bf16_t* Kt = (bf16_t*)smem; bf16_t* Vt = Kt + 128 * SLD;
    const bf16_t* P = (const bf16_t*)(a.ws + WS_P);
    const int tid = threadIdx.x, lane = tid & 63, w = tid >> 6, l15 = lane & 15, lq = lane >> 4;
    const float lg = log2_sigmoid(a.in[11 + dir][h]);
    const int tokbase = b * 256;
    __syncthreads();
#pragma unroll
    for (int i = 0; i < 8; ++i) { const int p = tid + 512 * i, key = p >> 4, d8 = (p & 15) * 8;
        const bf16_t* src = P + (size_t)(tokbase + key) * PLD + 512 + h * 128 + d8;
        const float wg = exp2f((float)(dir == 0 ? 255 - key : key) * lg);
        const u32x4 kv = *(const u32x4*)src; const u32x4 vv = *(const u32x4*)(src + 512);
        bf16_t* kd = Kt + d8 * SLD + key;
        kd[0] = f2bf(bf_lo(kv.x) * wg); kd[SLD] = f2bf(bf_hi(kv.x) * wg); kd[2 * SLD] = f2bf(bf_lo(kv.y) * wg); kd[3 * SLD] = f2bf(bf_hi(kv.y) * wg);
        kd[4 * SLD] = f2bf(bf_lo(kv.z) * wg); kd[5 * SLD] = f2bf(bf_hi(kv.z) * wg); kd[6 * SLD] = f2bf(bf_lo(kv.w) * wg); kd[7 * SLD] = f2bf(bf_hi(kv.w) * wg);
        bf16_t* vd = Vt + d8 * SLD + key;
        vd[0] = (bf16_t)(vv.x & 0xffffu); vd[SLD] = (bf16_t)(vv.x >> 16); vd[2 * SLD] = (bf16_t)(vv.y & 0xffffu); vd[3 * SLD] = (bf16_t)(vv.y >> 16);
        vd[4 * SLD] = (bf16_t)(vv.z & 0xffffu); vd[5 * SLD] = (bf16_t)(vv.z >> 16); vd[6 * SLD] = (bf16_t)(vv.w & 0xffffu); vd[7 * SLD] = (bf16_t)(vv.w >> 16); }
    __syncthreads();
    float* outp = a.out + (size_t)MTOK * DM + (size_t)dir * (32 * 4 * 16384) + (size_t)(b * 4 + h) * 16384;
#pragma unroll
    for (int nd = 0; nd < 8; ++nd) { f32x4 acc = (f32x4){0.f, 0.f, 0.f, 0.f};
#pragma unroll
        for (int ks = 0; ks < 8; ++ks) { const bf16x8 af = *(const bf16x8*)(Kt + (16 * w + l15) * SLD + 32 * ks + 8 * lq);
            const bf16x8 bfr = *(const bf16x8*)(Vt + (16 * nd + l15) * SLD + 32 * ks + 8 * lq); acc = MFMA16(af, bfr, acc); }
#pragma unroll
        for (int r = 0; r < 4; ++r) outp[(16 * w + 4 * lq + r) * 128 + 16 * nd + l15] = acc[r]; }
}
__device__ __forceinline__ float u4_elem(const u32x4& v, int e) { const unsigned w = v[e >> 1]; return (e & 1) ? bf_hi(w) : bf_lo(w); }
__device__ __forceinline__ void hy_unit(const Args& a, unsigned char* smem, int gidx, int cb) {
    bf16_t* U = (bf16_t*)smem;
    float* Fr = (float*)(smem + 49664);
    const bf16_t* P = (const bf16_t*)(a.ws + WS_P);
    const int tid = threadIdx.x, lane = tid & 63, w = tid >> 6;
    const bool isctx = gidx < 8; const int L = isctx ? 256 : 1024, nbl = L >> 5, tokbase = gidx * 1024, c0 = cb * 8;
    __syncthreads();
#pragma unroll 1
    for (int part = 0; part < 3; ++part) { const int colb = part * 512 + c0; const float* cw = a.in[13] + colb; const float* cbs = a.in[14] + colb;
#pragma unroll 1
        for (int it = 0; it < 2; ++it) { const int tok = tid + 512 * it; const int per = isctx ? 256 : 64, tl = tok & (per - 1);
            const bf16_t* src = P + (size_t)(tokbase + tok) * PLD + 2048 + colb;
            const u32x4 cur = *(const u32x4*)src; u32x4 prv = (u32x4){0u, 0u, 0u, 0u}, nxt = (u32x4){0u, 0u, 0u, 0u};
            if (tl != 0) prv = *(const u32x4*)(src - PLD);
            if (tl != per - 1) nxt = *(const u32x4*)(src + PLD);
#pragma unroll
            for (int e = 0; e < 8; ++e) { const float u = cw[e] * u4_elem(prv, e) + cw[1536 + e] * u4_elem(cur, e) + cw[3072 + e] * u4_elem(nxt, e) + cbs[e];
                U[(part * 8 + e) * ULD + tok] = f2bf(u); } } }
    __syncthreads();
    const int c = c0 + w; bf16_t* Uw = U + w * ULD; float* Frw = Fr + w * 2048;
    const int i = lane & 31, hh = lane >> 5;
    const float* FG = (const float*)(a.ws + (isctx ? WS_FG256 : WS_FG1024));
    const float* FPART = (const float*)(a.ws + WS_FPART);
    const int cbase = isctx ? 0 : 16, nch = isctx ? 16 : 64;
#pragma unroll 1
    for (int o = 0; o < 2; ++o) {
        float ps = 0.f;
        if (lane < nch) ps = FPART[(cbase + lane) * 2048 + o * 1024 + c] + FPART[(cbase + lane) * 2048 + o * 1024 + 512 + c];
        ps = wsum64(ps); const float inv = 1.0f / ps;
        const float* fsrc = FG + (size_t)(o * 512 + c) * (2 * L);
        for (int x = lane; x < 2 * L; x += 64) Frw[x] = fsrc[x] * inv;
        __syncthreads();
        f32x16 acc;
#pragma unroll
        for (int q = 0; q < 16; ++q) acc[q] = 0.f;
        const int tb = i & (nbl - 1);
#pragma unroll 1
        for (int d0 = -(nbl - 1); d0 <= nbl - 1; ++d0) {
            const int sb = tb - d0; const bool valid = (sb >= 0) && (sb < nbl);
#pragma unroll
            for (int ks = 0; ks < 2; ++ks) {
                const float* fp = Frw + (L - 1 - 32 * d0 - i + 16 * ks + 8 * hh);
                u32x4 aw; aw.x = cvt_pk_bf16(fp[0], fp[1]); aw.y = cvt_pk_bf16(fp[2], fp[3]); aw.z = cvt_pk_bf16(fp[4], fp[5]); aw.w = cvt_pk_bf16(fp[6], fp[7]);
                const int off = valid ? (32 * (i - d0) + 16 * ks + 8 * hh) : 0;
                u32x4 bw = *(const u32x4*)(Uw + off);
                if (!valid) bw = (u32x4){0u, 0u, 0u, 0u};
                acc = __builtin_amdgcn_mfma_f32_32x32x16_bf16(__builtin_bit_cast(bf16x8, aw), __builtin_bit_cast(bf16x8, bw), acc, 0, 0, 0);
            } }
        const float hb = a.in[21][o * 512 + c];
        const bf16_t* Xm = U + ((1 + o) * 8 + w) * ULD;
#pragma unroll
        for (int g = 0; g < 4; ++g) { const int tok4 = 32 * i + 8 * g + 4 * hh;
            const u32x2 sv = *(const u32x2*)(Uw + tok4); const u32x2 xv = *(const u32x2*)(Xm + tok4);
            const float z0 = bf_lo(xv.x) * (acc[4 * g + 0] + bf_lo(sv.x) * hb), z1 = bf_hi(xv.x) * (acc[4 * g + 1] + bf_hi(sv.x) * hb);
            const float z2 = bf_lo(xv.y) * (acc[4 * g + 2] + bf_lo(sv.y) * hb), z3 = bf_hi(xv.y) * (acc[4 * g + 3] + bf_hi(sv.y) * hb);
            u32x2 zo; zo.x = cvt_pk_bf16(z0, z1); zo.y = cvt_pk_bf16(z2, z3);
            *(u32x2*)(Uw + tok4) = zo; }
        __syncthreads();
    }
    bf16_t* Z = (bf16_t*)(a.ws + WS_Z);
#pragma unroll 1
    for (int it = 0; it < 2; ++it) { const int tok = tid + 512 * it;
        u32x4 wv; wv.x = (unsigned)U[0 * ULD + tok] | ((unsigned)U[1 * ULD + tok] << 16); wv.y = (unsigned)U[2 * ULD + tok] | ((unsigned)U[3 * ULD + tok] << 16);
        wv.z = (unsigned)U[4 * ULD + tok] | ((unsigned)U[5 * ULD + tok] << 16); wv.w = (unsigned)U[6 * ULD + tok] | ((unsigned)U[7 * ULD + tok] << 16);
        *(u32x4*)(Z + (size_t)(tokbase + tok) * 512 + c0) = wv; }
}
__global__ void __launch_bounds__(512, 2) mk_fwd(Args a) {
    extern __shared__ __attribute__((aligned(16))) unsigned char smem[];
    cg::grid_group grid = cg::this_grid();
    PG8_LAS unsigned char* lds = (PG8_LAS unsigned char*)smem;
    const int G = gridDim.x, bid = blockIdx.x, tid = threadIdx.x;
    unsigned char* ws = a.ws;
    bf16_t* Wt_in = (bf16_t*)(ws + WS_WIN); bf16_t* Wt_fi = (bf16_t*)(ws + WS_WFI); bf16_t* Wt_fo = (bf16_t*)(ws + WS_WFO);
    bf16_t* Wt_out = (bf16_t*)(ws + WS_WOUT); bf16_t* Wt_ret = (bf16_t*)(ws + WS_WRET); bf16_t* Wt_hy = (bf16_t*)(ws + WS_WHY);
    bf16_t* HB = (bf16_t*)(ws + WS_HB); bf16_t* Pb = (bf16_t*)(ws + WS_P); bf16_t* SG = (bf16_t*)(ws + WS_SG);
    bf16_t* Rb = (bf16_t*)(ws + WS_R); bf16_t* Zb = (bf16_t*)(ws + WS_Z); bf16_t* ACT = (bf16_t*)(ws + WS_ACT);
    const float* MOD = (const float*)(ws + WS_MOD);
    pg8::StaticOrder S;
    const int lo = a.ph_lo, hi = a.ph_hi;
#ifdef ONLY_PHASE
#define IN(k) ((k) == ONLY_PHASE && lo <= (k) && (k) < hi)
#else
#define IN(k) (lo <= (k) && (k) < hi)
#endif
#define SEAM(k) do { if (lo <= (k) && (k) + 1 < hi) { __threadfence(); grid.sync(); } } while (0)
    {
        if (IN(0)) {
            for (int t = bid; t < 352 + 4032; t += G) {
                if (t < 192) ph0_ada(a, t, (float*)smem);
                else if (t < 352) ph0_hidden(a, t - 192, (float*)smem);
                else { int q = t - 352;
                    if (q < 1408) ph0_wtile(a.in[10], Wt_in, 1024, NIN, q / 88, q % 88, false, (float*)smem);
                    else if ((q -= 1408) < 1408) ph0_wtile(a.in[25], Wt_fi, 1024, NIN, q / 88, q % 88, true, (float*)smem);
                    else if ((q -= 1408) < 704) ph0_wtile(a.in[26], Wt_fo, DFF, 1024, q / 16, q % 16, false, (float*)smem);
                    else if ((q -= 704) < 256) ph0_wtile(a.in[24], Wt_out, 1024, 1024, q / 16, q % 16, false, (float*)smem);
                    else if ((q -= 256) < 128) ph0_wtile(a.in[22], Wt_ret, 512, 1024, q / 16, q % 16, false, (float*)smem);
                    else { q -= 128; ph0_wtile(a.in[23], Wt_hy, 512, 1024, q / 16, q % 16, false, (float*)smem); } }
            }
        }
        SEAM(0);
        if (IN(1)) {
            for (int t = bid; t < 320; t += G) ph1_taps(a, t);
            norm_mod_rows(a, a.in[0], a.in[1], a.in[6], 0, 1024, HB);
        }
        SEAM(1);
        if (IN(2)) {
            pg8::Gemm g{HB, Wt_in, MTOK, NIN, 1024}; S.init(MTOK, NIN, G, bid); EpiInProj E{Pb, SG};
            pg8::gemm_phase<EpiInProj, pg8::StaticOrder>(lds, g, S, E, nullptr);
        }
        SEAM(2);
        if (IN(3)) {
            for (int u = bid; u < 1408; u += G) {
                if (u < 256) hy_unit(a, smem, 8 + (u >> 6), u & 63);
                else if (u < 384) { const int q = u - 256; ret_unit(a, smem, NCTX + (q >> 5) * 1024, 1024, q >> 5, (q >> 3) & 3, q & 7); }
                else if (u < 896) { const int q = u - 384; hy_unit(a, smem, q >> 6, q & 63); }
                else if (u < 1152) { const int q = u - 896; ret_unit(a, smem, (q >> 3) * 256, 256, -1, (q >> 1) & 3, q & 1); }
                else { const int q = u - 1152; state_unit(a, smem, q >> 3, (q >> 1) & 3, q & 1); }
            }
            __syncthreads();
        }
        SEAM(3);
        if (IN(4)) {
            S.init(MTOK, 1024, G, bid);
            { pg8::Gemm g{Rb, Wt_ret, MTOK, 1024, 512}; EpiGateT1 E{a.out, SG}; pg8::gemm_phase<EpiGateT1, pg8::StaticOrder>(lds, g, S, E, nullptr); }
            { pg8::Gemm g{Zb, Wt_hy, MTOK, 1024, 512}; EpiMix E{a.out, SG, HB}; pg8::gemm_phase<EpiMix, pg8::StaticOrder>(lds, g, S, E, nullptr); }
        }
        SEAM(4);
        if (IN(5)) {
            pg8::Gemm g{HB, Wt_out, MTOK, 1024, 1024}; S.init(MTOK, 1024, G, bid); EpiRes E{a.in[0], a.in[1], MOD + 2048, a.out};
            pg8::gemm_phase<EpiRes, pg8::StaticOrder>(lds, g, S, E, nullptr);
        }
        SEAM(5);
        if (IN(6)) {
            norm_mod_rows(a, a.out, a.out + (size_t)NCTX * DM, a.in[7], 3072, 4096, HB);
        }
        SEAM(6);
        if (IN(7)) {
            pg8::Gemm g{HB, Wt_fi, MTOK, NIN, 1024}; S.init(MTOK, NIN, G, bid); EpiSwiglu E{ACT};
            pg8::gemm_phase<EpiSwiglu, pg8::StaticOrder>(lds, g, S, E, nullptr);
        }
        SEAM(7);
        if (IN(8)) {
            pg8::Gemm g{ACT, Wt_fo, MTOK, 1024, DFF}; S.init(MTOK, 1024, G, bid); EpiRes E{a.out, a.out + (size_t)NCTX * DM, MOD + 5120, a.out};
            pg8::gemm_phase<EpiRes, pg8::StaticOrder>(lds, g, S, E, nullptr);
        }
        SEAM(8);
        if (IN(9)) {
            const int lane = tid & 63, w = tid >> 6; const float* fg = a.in[27];
            for (int row = bid * 8 + w; row < MTOK; row += G * 8) { float* xr = a.out + (size_t)row * DM;
                f32x4 v[4]; float ss = 0.f;
#pragma unroll
                for (int i = 0; i < 4; ++i) { v[i] = *(const f32x4*)(xr + i * 256 + lane * 4); ss += v[i][0] * v[i][0] + v[i][1] * v[i][1] + v[i][2] * v[i][2] + v[i][3] * v[i][3]; }
                ss = wsum64(ss); const float rstd = rsqrtf(ss * (1.0f / 1024.0f) + 1e-6f);
#pragma unroll
                for (int i = 0; i < 4; ++i) { const f32x4 g = *(const f32x4*)(fg + i * 256 + lane * 4); *(f32x4*)(xr + i * 256 + lane * 4) = v[i] * rstd * g; } }
        }
    }
}

extern "C" void kernel_launch(void* const* d_in, const int* in_sizes, int n_in, void* d_out, int out_size, void* d_ws, size_t ws_size, hipStream_t stream) {
    static int grid = 0;
    if (grid == 0) {
        if (n_in != 28 || in_sizes[0] != NCTX * DM || out_size != MTOK * DM + 2 * 32 * 4 * 16384 || ws_size < WS_END) {
            fprintf(stderr, "kernel_launch: unexpected shapes (n_in %d, in0 %d, out %d, ws %zu); nothing launched\n", n_in, n_in > 0 ? in_sizes[0] : -1, out_size, ws_size); grid = -1; return; }
        int dev = 0, cus = 0, per_cu = 0;
        if (hipGetDevice(&dev) != hipSuccess || hipDeviceGetAttribute(&cus, hipDeviceAttributeMultiprocessorCount, dev) != hipSuccess) { grid = -1; return; }
        if (hipFuncSetAttribute((const void*)mk_fwd, hipFuncAttributeMaxDynamicSharedMemorySize, LDS_BYTES) != hipSuccess) { fprintf(stderr, "kernel_launch: hipFuncSetAttribute failed\n"); grid = -1; return; }
        if (hipOccupancyMaxActiveBlocksPerMultiprocessor(&per_cu, (const void*)mk_fwd, 512, LDS_BYTES) != hipSuccess || per_cu < 1) { fprintf(stderr, "kernel_launch: occupancy query says %d\n", per_cu); per_cu = 1; }
        (void)hipGetLastError();
        grid = cus * 1;
    }
    if (grid < 0) return;
    Args a{};
    for (int i = 0; i < 28; ++i) a.in[i] = (const float*)d_in[i];
    a.out = (float*)d_out; a.ws = (unsigned char*)d_ws;
#if MK_ONE_LAUNCH
    a.ph_lo = 0; a.ph_hi = N_PHASES;
    void* args[] = {&a};
    hipError_t e = hipLaunchCooperativeKernel((const void*)mk_fwd, dim3(grid), dim3(512), args, LDS_BYTES, stream);
    if (e != hipSuccess) fprintf(stderr, "kernel_launch: cooperative launch failed: %s (grid %d)\n", hipGetErrorString(e), grid);
#else
    for (int ph = 0; ph < N_PHASES; ++ph) { a.ph_lo = ph; a.ph_hi = ph + 1;
        hipLaunchKernelGGL(mk_fwd, dim3(grid), dim3(512), LDS_BYTES, stream, a); }
#endif
}
```

```cpp
#include <hip/hip_runtime.h>
#include <hip/hip_cooperative_groups.h>
#include <cstdio>
#include <cstdint>
namespace cg = cooperative_groups;
namespace pg8 {
#define PG8_LAS __attribute__((address_space(3)))
typedef unsigned short bf16_t;
typedef short bf16x8 __attribute__((ext_vector_type(8)));
typedef float f32x4 __attribute__((ext_vector_type(4)));
typedef unsigned u32x4 __attribute__((ext_vector_type(4)));
constexpr int BM = 256, BK = 64, HALF = 128, HTB = HALF * BK * 2  , STAGE_BYTES = 8 * HTB, NXCD = 8, WGM = 8;

__host__ __device__ __forceinline__ int lds_byte(int r, int c) { const int st = (r >> 4) * 2 + (c >> 5), rr = r & 15, cc = c & 31, ob = rr * 64 + cc * 2; return st * 1024 + (ob ^ (((ob >> 9) & 1) << 5)); }
__host__ __device__ __forceinline__ void stage_rc(int b, int& R, int& C) { const int st = b / 1024, sb = b % 1024, swz = sb ^ (((sb >> 9) & 1) << 5); R = (st >> 1) * 16 + swz / 64; C = (st & 1) * 32 + (swz % 64) / 2; }
__host__ __device__ __forceinline__ int perm32(int rho) { const int n = rho >> 4, i = rho & 15; return 8 * (i >> 2) + 4 * n + (i & 3); }

struct Unit { int pm, pn; };
struct Gemm { const bf16_t* A; const bf16_t* Bt; int M, N, K; };

struct StaticOrder {
    int nM, nN, nwg, G, c;
    __host__ __device__ void init(int M, int N, int G_, int c_) { nM = M / BM; nN = N / BM; nwg = nM * nN; G = G_; c = c_; }
    __host__ __device__ bool next(int i, Unit& u) const {
        const long L = (long)i * G + c; if (L >= nwg) return false;
        int wgid = (int)L; { const int q = nwg / NXCD, r = nwg % NXCD, xcd = wgid % NXCD, off = wgid / NXCD; wgid = (xcd < r ? xcd * (q + 1) : r * (q + 1) + (xcd - r) * q) + off; }
        const int nig = WGM * nN, gid = wgid / nig, fm = gid * WGM, gsz = (nM - fm) < WGM ? (nM - fm) : WGM;
        u.pm = fm + ((wgid % nig) % gsz); u.pn = (wgid % nig) / gsz; return true;
    }
    __device__ __forceinline__ void a_ready(const Unit&) const {}
    __device__ __forceinline__ void done(const Unit&) const {}
};
__device__ __forceinline__ unsigned cvt_pk_bf16(float lo, float hi) { unsigned r; asm volatile("v_cvt_pk_bf16_f32 %0, %1, %2" : "=v"(r) : "v"(lo), "v"(hi)); return r; }

template <class Epi, class Sched, bool STAMP = false>
__device__ __forceinline__ void gemm_phase(PG8_LAS unsigned char* lds, const Gemm g, const Sched& S, const Epi& E, unsigned long long* stamps) {
    const int tid = threadIdx.x, wid = __builtin_amdgcn_readfirstlane(tid >> 6), lane = tid & 63, wr = wid >> 2, wc = wid & 3, fr = lane & 15, fq = lane >> 4;
    const int K = g.K, nt = K / BK;
    int ts_lo = 0, ts_hi = 0, nts = 0; const unsigned long long rt_entry = STAMP ? (unsigned long long)wall_clock64() : 0ull;
#define PG8_STAMP() do { if (STAMP && wid == 0 && nts < 64) { const unsigned long long _c = (unsigned long long)clock64(); \
        ts_lo = (lane == nts) ? (int)(unsigned)_c : ts_lo; ts_hi = (lane == nts) ? (int)(unsigned)(_c >> 32) : ts_hi; ++nts; } } while (0)
    PG8_STAMP();
    unsigned voffA[2], voffB[2];
#pragma unroll
    for (int i = 0; i < 2; ++i) { int R, C; stage_rc(tid * 16 + i * 8192, R, C); const int Rb = Epi::PERM ? ((R & ~31) + perm32(R & 31)) : R;
        voffA[i] = (unsigned)(R * K + C) * 2u; voffB[i] = (unsigned)(Rb * K + C) * 2u; }
    const size_t kstep = (size_t)(BK * 2);
    const size_t hstep = (size_t)HALF * K * 2;
    const size_t tstep = 2 * hstep;
    const unsigned ldsw = (unsigned)wid * 1024u;
    const int aoff = lds_byte(wr * 64 + fr, fq * 8), boff = lds_byte(wc * 32 + fr, fq * 8);
#define PG8_SA(b, h) (((b) * 2 + (h)) * HTB)
#define PG8_SB(b, h) ((4 + (b) * 2 + (h)) * HTB)
#define PG8_STAGE(bufoff, gbase, voff) do { _Pragma("unroll") for (int _i = 0; _i < 2; ++_i) \
        __builtin_amdgcn_global_load_lds((const unsigned*)((const char*)(gbase) + (voff)[_i]), (PG8_LAS unsigned*)(lds + (bufoff) + ldsw + _i * 8192), 16, 0, 0); } while (0)
#define PG8_LDA(dst, b, h) do { _Pragma("unroll") for (int m = 0; m < 4; ++m) _Pragma("unroll") for (int k = 0; k < 2; ++k) dst[m][k] = *(const PG8_LAS bf16x8*)(lds + PG8_SA(b, h) + aoff + m * 2048 + k * 1024); } while (0)
#define PG8_LDB(dst, b, h) do { _Pragma("unroll") for (int n = 0; n < 2; ++n) _Pragma("unroll") for (int k = 0; k < 2; ++k) dst[n][k] = *(const PG8_LAS bf16x8*)(lds + PG8_SB(b, h) + boff + n * 2048 + k * 1024); } while (0)
#define PG8_MMA(ai, bj, At, Bt) do { __builtin_amdgcn_s_setprio(1); _Pragma("unroll") for (int m = 0; m < 4; ++m) _Pragma("unroll") for (int n = 0; n < 2; ++n) _Pragma("unroll") for (int k = 0; k < 2; ++k) \
        acc[ai][bj][m][n] = __builtin_amdgcn_mfma_f32_16x16x32_bf16(Bt[n][k], At[m][k], acc[ai][bj][m][n], 0, 0, 0); __builtin_amdgcn_s_setprio(0); } while (0)
#define PG8_WAIT_V(n) asm volatile("s_waitcnt vmcnt(" #n ")" ::: "memory")
#define PG8_WAIT_L(n) asm volatile("s_waitcnt lgkmcnt(" #n ")" ::: "memory")
#define PG8_BAR __builtin_amdgcn_s_barrier()
#define PG8_SCHED __builtin_amdgcn_sched_barrier(0)
    Unit cur, nxt; int ui = 0;
    if (!S.next(0, cur)) return;
    f32x4 acc[2][2][4][2];
#pragma unroll
    for (int a = 0; a < 2; ++a)
#pragma unroll
        for (int b = 0; b < 2; ++b)
#pragma unroll
            for (int m = 0; m < 4; ++m)
#pragma unroll
                for (int n = 0; n < 2; ++n) acc[a][b][m][n] = (f32x4){0.f, 0.f, 0.f, 0.f};
    bf16x8 At[4][2], B0[2][2], B1[2][2];
    const char* cA = (const char*)g.A + (size_t)cur.pm * tstep; const char* cB = (const char*)g.Bt + (size_t)cur.pn * tstep;
    S.a_ready(cur);
    PG8_STAGE(PG8_SB(0, 0), cB, voffB); PG8_STAGE(PG8_SA(0, 0), cA, voffA); PG8_STAGE(PG8_SB(0, 1), cB + hstep, voffB); PG8_STAGE(PG8_SA(0, 1), cA + hstep, voffA);
    if (wr == 1) PG8_BAR;
    PG8_WAIT_V(4); PG8_BAR;
    PG8_STAGE(PG8_SB(1, 0), cB + kstep, voffB); PG8_STAGE(PG8_SA(1, 0), cA + kstep, voffA); PG8_STAGE(PG8_SB(1, 1), cB + hstep + kstep, voffB);
    PG8_WAIT_V(6); PG8_BAR;
    PG8_STAMP();
    for (;;) {
        const bool has_next = S.next(ui + 1, nxt);
        const char* nA = has_next ? (const char*)g.A + (size_t)nxt.pm * tstep : cA; const char* nB = has_next ? (const char*)g.Bt + (size_t)nxt.pn * tstep : cB;
        for (int t = 0; t < nt; t += 2) {
            const bool last = (t == nt - 2);
            const char* a1 = cA + (size_t)(t + 1) * kstep;
            const char* a2 = last ? nA : cA + (size_t)(t + 2) * kstep; const char* b2 = last ? nB : cB + (size_t)(t + 2) * kstep;
            const char* a3 = a2 + kstep; const char* b3 = b2 + kstep;
            if (last && has_next) S.a_ready(nxt);
            PG8_LDB(B0, 0, 0); PG8_SCHED; PG8_LDA(At, 0, 0); PG8_STAGE(PG8_SA(1, 1), a1 + hstep, voffA);
            PG8_WAIT_L(8); PG8_BAR; PG8_WAIT_L(0); PG8_MMA(0, 0, At, B0); PG8_BAR; PG8_SCHED;
            PG8_LDB(B1, 0, 1); PG8_STAGE(PG8_SB(0, 0), b2, voffB);
            PG8_BAR; PG8_WAIT_L(0); PG8_MMA(0, 1, At, B1); PG8_BAR;
            PG8_LDA(At, 0, 1); PG8_STAGE(PG8_SA(0, 0), a2, voffA);
            PG8_BAR; PG8_WAIT_L(0); PG8_MMA(1, 0, At, B0); PG8_BAR; PG8_SCHED;
            PG8_STAGE(PG8_SB(0, 1), b2 + hstep, voffB);
            PG8_WAIT_V(6); PG8_BAR; PG8_MMA(1, 1, At, B1); PG8_BAR;
            PG8_LDB(B0, 1, 0); PG8_SCHED; PG8_LDA(At, 1, 0); PG8_STAGE(PG8_SA(0, 1), a2 + hstep, voffA);
            PG8_WAIT_L(8); PG8_BAR; PG8_WAIT_L(0); PG8_MMA(0, 0, At, B0); PG8_BAR; PG8_SCHED;
            PG8_LDB(B1, 1, 1); PG8_STAGE(PG8_SB(1, 0), b3, voffB);
            PG8_BAR; PG8_WAIT_L(0); PG8_MMA(0, 1, At, B1); PG8_BAR;
            PG8_LDA(At, 1, 1); PG8_STAGE(PG8_SA(1, 0), a3, voffA);
            PG8_BAR; PG8_WAIT_L(0); PG8_MMA(1, 0, At, B0); PG8_BAR; PG8_SCHED;
            PG8_STAGE(PG8_SB(1, 1), b3 + hstep, voffB);
            PG8_WAIT_V(6); PG8_BAR; PG8_MMA(1, 1, At, B1); PG8_BAR;
        }
        PG8_STAMP();
        if constexpr (!Epi::AFTER_DRAIN) { E(acc, cur, wr, wc, fr, fq); S.done(cur); }
        PG8_STAMP();
        if (!has_next) break;
#pragma unroll
        for (int a = 0; a < 2; ++a)
#pragma unroll
            for (int b = 0; b < 2; ++b)
#pragma unroll
                for (int m = 0; m < 4; ++m)
#pragma unroll
                    for (int n = 0; n < 2; ++n) acc[a][b][m][n] = (f32x4){0.f, 0.f, 0.f, 0.f};
        cur = nxt; cA = nA; cB = nB; ++ui;
    }
    PG8_WAIT_V(0);
    if (wr == 0) PG8_BAR;
    PG8_BAR;
    if constexpr (Epi::AFTER_DRAIN) { E.fused(acc, cur, wr, wc, fr, fq, lds, wid, lane); S.done(cur); }
    PG8_STAMP();
    if (STAMP && wid == 0) { stamps[lane] = lane < nts ? (((unsigned long long)(unsigned)ts_hi << 32) | (unsigned)ts_lo) : 0ull;
        if (lane == 62) stamps[62] = rt_entry; if (lane == 63) stamps[63] = (unsigned long long)wall_clock64(); }
#undef PG8_STAMP
#undef PG8_SA
#undef PG8_SB
#undef PG8_STAGE
#undef PG8_LDA
#undef PG8_LDB
#undef PG8_MMA
#undef PG8_WAIT_V
#undef PG8_WAIT_L
#undef PG8_BAR
#undef PG8_SCHED
}
}

using pg8::bf16_t; using pg8::bf16x8; using pg8::f32x4; using pg8::u32x4; using pg8::Unit; using pg8::cvt_pk_bf16;
typedef float f32x16 __attribute__((ext_vector_type(16)));
typedef unsigned u32x2 __attribute__((ext_vector_type(2)));

#ifndef MK_ONE_LAUNCH
#define MK_ONE_LAUNCH 1
#endif

constexpr int DM = 1024, NCTX = 8192, MTOK = 12288, NIN = 5632, DFF = 2816, PLD = 3584, SGLD = 2048, NMOD = 6144;
constexpr int N_PHASES = 10;
constexpr size_t MiB = 1u << 20;
constexpr size_t WS_MOD = 1 * MiB, WS_H2F = WS_MOD + 128 * 1024, WS_FPART = WS_MOD + 512 * 1024;
constexpr size_t WS_WIN = 3 * MiB, WS_WFI = 14 * MiB, WS_WFO = 25 * MiB, WS_WOUT = 31 * MiB, WS_WRET = 33 * MiB, WS_WHY = 34 * MiB;
constexpr size_t WS_FG256 = 35 * MiB, WS_FG1024 = 37 * MiB, WS_HB = 45 * MiB, WS_R = 69 * MiB, WS_Z = 81 * MiB, WS_SG = 93 * MiB, WS_P = 141 * MiB, WS_ACT = 141 * MiB, WS_END = 225 * MiB;
constexpr int LDS_BYTES = 147456;

struct Args { const float* in[28]; float* out; unsigned char* ws; int ph_lo, ph_hi; };

__device__ __forceinline__ float bf_lo(unsigned w) { return __uint_as_float(w << 16); }
__device__ __forceinline__ float bf_hi(unsigned w) { return __uint_as_float(w & 0xffff0000u); }
__device__ __forceinline__ float bf2f(bf16_t b) { return __uint_as_float(((unsigned)b) << 16); }
__device__ __forceinline__ bf16_t f2bf(float f) { return (bf16_t)(cvt_pk_bf16(f, 0.0f) & 0xffffu); }
__device__ __forceinline__ float wsum16(float v) { v += __shfl_xor(v, 1); v += __shfl_xor(v, 2); v += __shfl_xor(v, 4); v += __shfl_xor(v, 8); return v; }
__device__ __forceinline__ float wsum64(float v) { v = wsum16(v); v += __shfl_xor(v, 16); v += __shfl_xor(v, 32); return v; }
__device__ __forceinline__ float log2_sigmoid(float x) { return -log1pf(expf(-x)) * 1.4426950408889634f; }
__device__ __forceinline__ int row_group(int row) { return row < NCTX ? 0 : 1 + ((row - NCTX) >> 10); }

__device__ __forceinline__ float act_apply(float v, int mode) {
    if (mode == 0) return v;
    if (mode == 1) return v * 0.08838834764831845f;
    const float s = 1.0f / (1.0f + __expf(-v));
    return mode == 2 ? v * s : s;
}
struct EpiInProj {
    static constexpr bool PERM = true, AFTER_DRAIN = false;
    bf16_t* P; bf16_t* SG;
    __device__ __forceinline__ void operator()(const f32x4 (&acc)[2][2][4][2], const Unit& u, int wr, int wc, int fr, int fq) const {
        const int row0 = u.pm * 256 + wr * 64 + fr, pn = u.pn;
        bf16_t* base; int ldc, colt, mode;
        if (pn < 14) { base = P; ldc = PLD; colt = pn * 256; mode = (pn == 2 || pn == 3) ? 1 : ((pn == 6 || pn == 7) ? 2 : 0); }
        else { base = SG; ldc = SGLD; colt = pn * 256 - PLD; mode = 3; }
        const int col0 = colt + wc * 32 + 8 * fq;
#pragma unroll
        for (int ai = 0; ai < 2; ++ai)
#pragma unroll
            for (int m = 0; m < 4; ++m) { bf16_t* rowp = base + (size_t)(row0 + ai * 128 + m * 16) * ldc + col0;
#pragma unroll
                for (int bj = 0; bj < 2; ++bj) { const f32x4 v0 = acc[ai][bj][m][0], v1 = acc[ai][bj][m][1];
                    u32x4 w; w.x = cvt_pk_bf16(act_apply(v0[0], mode), act_apply(v0[1], mode)); w.y = cvt_pk_bf16(act_apply(v0[2], mode), act_apply(v0[3], mode));
                    w.z = cvt_pk_bf16(act_apply(v1[0], mode), act_apply(v1[1], mode)); w.w = cvt_pk_bf16(act_apply(v1[2], mode), act_apply(v1[3], mode));
                    *(u32x4*)(rowp + bj * 128) = w; } }
    }
};
struct EpiGateT1 {
    static constexpr bool PERM = false, AFTER_DRAIN = false;
    float* T1; const bf16_t* SG;
    __device__ __forceinline__ void operator()(const f32x4 (&acc)[2][2][4][2], const Unit& u, int wr, int wc, int fr, int fq) const {
        const int row0 = u.pm * 256 + wr * 64 + fr, col0 = u.pn * 256 + wc * 32 + 4 * fq;
#pragma unroll
        for (int ai = 0; ai < 2; ++ai)
#pragma unroll
            for (int m = 0; m < 4; ++m) { const int row = row0 + ai * 128 + m * 16;
#pragma unroll
                for (int bj = 0; bj < 2; ++bj)
#pragma unroll
                    for (int n = 0; n < 2; ++n) { const int col = col0 + bj * 128 + n * 16;
                        const u32x2 g = *(const u32x2*)(SG + (size_t)row * SGLD + col);
                        const f32x4 gv = {bf_lo(g.x), bf_hi(g.x), bf_lo(g.y), bf_hi(g.y)};
                        *(f32x4*)(T1 + (size_t)row * DM + col) = acc[ai][bj][m][n] * gv; }
                asm volatile("" ::: "memory"); }
    }
};
struct EpiMix {
    static constexpr bool PERM = false, AFTER_DRAIN = false;
    const float* T1; const bf16_t* SG; bf16_t* MIX;
    __device__ __forceinline__ void operator()(const f32x4 (&acc)[2][2][4][2], const Unit& u, int wr, int wc, int fr, int fq) const {
        const int row0 = u.pm * 256 + wr * 64 + fr, col0 = u.pn * 256 + wc * 32 + 4 * fq;
#pragma unroll
        for (int ai = 0; ai < 2; ++ai)
#pragma unroll
            for (int m = 0; m < 4; ++m) { const int row = row0 + ai * 128 + m * 16;
#pragma unroll
                for (int bj = 0; bj < 2; ++bj)
#pragma unroll
                    for (int n = 0; n < 2; ++n) { const int col = col0 + bj * 128 + n * 16;
                        const u32x2 g = *(const u32x2*)(SG + (size_t)row * SGLD + 1024 + col);
                        const f32x4 gv = {bf_lo(g.x), bf_hi(g.x), bf_lo(g.y), bf_hi(g.y)};
                        const f32x4 t = *(const f32x4*)(T1 + (size_t)row * DM + col);
                        const f32x4 r = t + acc[ai][bj][m][n] * gv;
                        u32x2 o; o.x = cvt_pk_bf16(r[0], r[1]); o.y = cvt_pk_bf16(r[2], r[3]);
                        *(u32x2*)(MIX + (size_t)row * DM + col) = o; }
                asm volatile("" ::: "memory"); }
    }
};
struct EpiRes {
    static constexpr bool PERM = false, AFTER_DRAIN = false;
    const float* b0; const float* b1;
    const float* gate;
    float* OUT;
    __device__ __forceinline__ void operator()(const f32x4 (&acc)[2][2][4][2], const Unit& u, int wr, int wc, int fr, int fq) const {
        const int row0 = u.pm * 256 + wr * 64 + fr, col0 = u.pn * 256 + wc * 32 + 4 * fq;
        const int grp = u.pm < 32 ? 0 : 1 + ((u.pm - 32) >> 2);
        const float* gp = gate + grp * NMOD + col0;
        f32x4 gv[2][2];
#pragma unroll
        for (int bj = 0; bj < 2; ++bj)
#pragma unroll
            for (int n = 0; n < 2; ++n) gv[bj][n] = *(const f32x4*)(gp + bj * 128 + n * 16);
#pragma unroll
        for (int ai = 0; ai < 2; ++ai)
#pragma unroll
            for (int m = 0; m < 4; ++m) { const int row = row0 + ai * 128 + m * 16;
                const float* bp = (u.pm < 32 ? b0 + (size_t)row * DM : b1 + (size_t)(row - NCTX) * DM) + col0;
                float* op = OUT + (size_t)row * DM + col0;
#pragma unroll
                for (int bj = 0; bj < 2; ++bj)
#pragma unroll
                    for (int n = 0; n < 2; ++n) { const f32x4 b = *(const f32x4*)(bp + bj * 128 + n * 16);
                        *(f32x4*)(op + bj * 128 + n * 16) = b + gv[bj][n] * acc[ai][bj][m][n]; } }
    }
};
struct EpiSwiglu {
    static constexpr bool PERM = true, AFTER_DRAIN = false;
    bf16_t* ACT;
    __device__ __forceinline__ void operator()(const f32x4 (&acc)[2][2][4][2], const Unit& u, int wr, int wc, int fr, int fq) const {
        const int row0 = u.pm * 256 + wr * 64 + fr, col0 = u.pn * 128 + wc * 32 + 8 * fq;
#pragma unroll
        for (int ai = 0; ai < 2; ++ai)
#pragma unroll
            for (int m = 0; m < 4; ++m) { bf16_t* rowp = ACT + (size_t)(row0 + ai * 128 + m * 16) * DFF + col0;
                float r[8];
#pragma unroll
                for (int n = 0; n < 2; ++n)
#pragma unroll
                    for (int j = 0; j < 4; ++j) { const float av = acc[ai][0][m][n][j], bv = acc[ai][1][m][n][j]; r[n * 4 + j] = av / (1.0f + __expf(-av)) * bv; }
                u32x4 w; w.x = cvt_pk_bf16(r[0], r[1]); w.y = cvt_pk_bf16(r[2], r[3]); w.z = cvt_pk_bf16(r[4], r[5]); w.w = cvt_pk_bf16(r[6], r[7]);
                *(u32x4*)rowp = w; }
    }
};

__device__ __forceinline__ void ph0_ada(const Args& a, int task, float* sm) {
    const int tid = threadIdx.x;
    float* sc = sm; float* red = sm + 5120;
    for (int i = tid; i < 5120; i += 512) { const int g = i >> 10, k = i & 1023; const float v = g == 0 ? a.in[5][k] : a.in[4][(g - 1) * 1024 + k]; sc[i] = v / (1.0f + expf(-v)); }
    __syncthreads();
    const int nl = tid & 31, kg = tid >> 5, n = task * 32 + nl;
    float a0 = 0.f, a1 = 0.f, a2 = 0.f, a3 = 0.f, a4 = 0.f;
    const float* w = a.in[8] + (size_t)(kg * 64) * NMOD + n;
#pragma unroll 8
    for (int k = 0; k < 64; ++k) { const float wv = w[(size_t)k * NMOD]; const int kk = kg * 64 + k;
        a0 += sc[kk] * wv; a1 += sc[1024 + kk] * wv; a2 += sc[2048 + kk] * wv; a3 += sc[3072 + kk] * wv; a4 += sc[4096 + kk] * wv; }
    red[(kg * 5 + 0) * 32 + nl] = a0; red[(kg * 5 + 1) * 32 + nl] = a1; red[(kg * 5 + 2) * 32 + nl] = a2; red[(kg * 5 + 3) * 32 + nl] = a3; red[(kg * 5 + 4) * 32 + nl] = a4;
    __syncthreads();
    if (tid < 160) { const int g = tid >> 5, l = tid & 31; float s = a.in[9][task * 32 + l];
        for (int q = 0; q < 16; ++q) s += red[(q * 5 + g) * 32 + l];
        ((float*)(a.ws + WS_MOD))[g * NMOD + task * 32 + l] = s; }
    __syncthreads();
}
__device__ __forceinline__ void ph0_hidden(const Args& a, int task, float* sm) {
    float* zf = sm; float* h1s = sm + 320;
    const int tid = threadIdx.x, rr = tid >> 6, j = tid & 63, r = task * 8 + rr;
    const int L = r < 256 ? 256 : 1024, t = r < 256 ? r : r - 256;
    if (j < 33) { float v;
        if (j == 0) v = (float)t / (float)(L - 1);
        else { const int b = (j - 1) & 15; const float band = 1e-4f + (float)b * ((15.0f - 1e-4f) / 15.0f); const float ang = 6.283185307179586f * (float)t / (float)L;
            v = j <= 16 ? cosf(band * ang) : -sinf(band * ang); }
        zf[rr * 40 + j] = v; }
    __syncthreads();
    const float fq = a.in[20][j];
    float s = a.in[16][j];
    for (int e = 0; e < 33; ++e) s += zf[rr * 40 + e] * a.in[15][e * 64 + j];
    h1s[rr * 64 + j] = sinf(fq * s);
    __syncthreads();
    float s2 = a.in[18][j];
    for (int k = 0; k < 64; ++k) s2 += h1s[rr * 64 + k] * a.in[17][k * 64 + j];
    ((float*)(a.ws + WS_H2F))[r * 64 + j] = sinf(fq * s2);
    __syncthreads();
}
__device__ __forceinline__ void ph0_wtile(const float* W, bf16_t* Wt, int K, int N, int kt, int nt, bool permffn, float* sm) {
    const int tid = threadIdx.x;
    { const int k = tid >> 3, n8 = (tid & 7) * 8; const float* src = W + (size_t)(kt * 64 + k) * N + nt * 64 + n8;
      const f32x4 v0 = *(const f32x4*)src, v1 = *(const f32x4*)(src + 4);
      float* d = sm + k * 65 + n8; d[0] = v0[0]; d[1] = v0[1]; d[2] = v0[2]; d[3] = v0[3]; d[4] = v1[0]; d[5] = v1[1]; d[6] = v1[2]; d[7] = v1[3]; }
    __syncthreads();
    { const int n = tid >> 3, k8 = (tid & 7) * 8; const float* s = sm + k8 * 65 + n;
      u32x4 w; w.x = cvt_pk_bf16(s[0], s[65]); w.y = cvt_pk_bf16(s[130], s[195]); w.z = cvt_pk_bf16(s[260], s[325]); w.w = cvt_pk_bf16(s[390], s[455]);
      int nn = nt * 64 + n;
      if (permffn) nn = nn < DFF ? ((nn >> 7) * 256 + (nn & 127)) : (((nn - DFF) >> 7) * 256 + 128 + ((nn - DFF) & 127));
      *(u32x4*)(Wt + (size_t)nn * K + kt * 64 + k8) = w; }
    __syncthreads();
}
__device__ __forceinline__ void ph1_taps(const Args& a, int task) {
    const int ch = task >> 2, cb = task & 3, col = cb * 512 + (int)threadIdx.x;
    const bool small = ch < 16; const int L = small ? 256 : 1024, t0 = small ? ch * 16 : (ch - 16) * 16, rowbase = small ? 0 : 256;
    float w3c[64];
#pragma unroll
    for (int k = 0; k < 64; ++k) w3c[k] = a.in[19][k * 2048 + col];
    const int o = col >> 10, dir = (col >> 9) & 1, cch = col & 511;
    const float dmin = -3.0701134573253945f, dmax = -15.350567286626973f;
    const float delta = fabsf(dmin + (float)cch * ((dmax - dmin) / 511.0f));
    float* fg = (float*)(a.ws + (small ? WS_FG256 : WS_FG1024)) + (size_t)(o * 512 + cch) * (2 * L);
    const float* h2 = (const float*)(a.ws + WS_H2F);
    float psum = 0.f;
#pragma unroll 1
    for (int tt = 0; tt < 16; ++tt) { const int t = t0 + tt; const float* hr = h2 + (size_t)(rowbase + t) * 64;
        float s = 0.f;
#pragma unroll
        for (int k = 0; k < 64; ++k) s += hr[k] * w3c[k];
        const float v = s * expf(-((float)t / (float)(L - 1)) * delta);
        if (dir == 0) { fg[L - 1 - t] = v; psum += fabsf(v); }
        else if (t >= 1) { fg[L - 1 + t] = v; psum += fabsf(v); } }
    if (dir == 1 && t0 == 0) fg[2 * L - 1] = 0.f;
    ((float*)(a.ws + WS_FPART))[ch * 2048 + col] = psum;
}
__device__ __forceinline__ void norm_mod_rows(const Args& a, const float* s0, const float* s1, const float* gw, int shoff, int scoff, bf16_t* dst) {
    const int lane = threadIdx.x & 63, w = threadIdx.x >> 6;
    const float* MOD = (const float*)(a.ws + WS_MOD);
    for (int row = blockIdx.x * 8 + w; row < MTOK; row += gridDim.x * 8) {
        const float* xr = row < NCTX ? s0 + (size_t)row * DM : s1 + (size_t)(row - NCTX) * DM;
        const float* mg = MOD + row_group(row) * NMOD;
        f32x4 v[4]; float ss = 0.f;
#pragma unroll
        for (int i = 0; i < 4; ++i) { v[i] = *(const f32x4*)(xr + i * 256 + lane * 4); ss += v[i][0] * v[i][0] + v[i][1] * v[i][1] + v[i][2] * v[i][2] + v[i][3] * v[i][3]; }
        ss = wsum64(ss);
        const float rstd = rsqrtf(ss * (1.0f / 1024.0f) + 1e-6f);
#pragma unroll
        for (int i = 0; i < 4; ++i) { const int c = i * 256 + lane * 4;
            const f32x4 g = *(const f32x4*)(gw + c), sc = *(const f32x4*)(mg + scoff + c), sh = *(const f32x4*)(mg + shoff + c);
            const f32x4 y = v[i] * rstd * g * (sc + 1.0f) + sh;
            u32x2 o; o.x = cvt_pk_bf16(y[0], y[1]); o.y = cvt_pk_bf16(y[2], y[3]);
            *(u32x2*)(dst + (size_t)row * DM + c) = o; }
    }
}
constexpr int RLD = 136, SLD = 264, ULD = 1032;
#define MFMA16(a_, b_, c_) __builtin_amdgcn_mfma_f32_16x16x32_bf16((a_), (b_), (c_), 0, 0, 0)
__device__ __forceinline__ void ret_unit(const Args& a, unsigned char* smem, int tokbase, int L, int bsel, int h, int qt) {
    bf16_t* Ks = (bf16_t*)smem; bf16_t* Vt = Ks + 128 * RLD; bf16_t* Ps = Vt + 128 * RLD;
    const bf16_t* P = (const bf16_t*)(a.ws + WS_P);
    const int tid = threadIdx.x, lane = tid & 63, w = tid >> 6, l15 = lane & 15, lq = lane >> 4;
    const float lgf = log2_sigmoid(a.in[11][h]), lgb = log2_sigmoid(a.in[12][h]);
    const int t0 = qt * 128;
    bf16x8 qf[4];
    { const bf16_t* qp = P + (size_t)(tokbase + t0 + 16 * w + l15) * PLD + h * 128 + 8 * lq;
#pragma unroll
      for (int ks = 0; ks < 4; ++ks) qf[ks] = *(const bf16x8*)(qp + 32 * ks); }
    f32x4 oacc[8];
#pragma unroll
    for (int nd = 0; nd < 8; ++nd) oacc[nd] = (f32x4){0.f, 0.f, 0.f, 0.f};
    bf16_t* Pw = Ps + w * 16 * RLD;
    const int nkt = L >> 7;
#pragma unroll 1
    for (int kt = 0; kt < nkt; ++kt) {
        __syncthreads();
#pragma unroll
        for (int i = 0; i < 4; ++i) { const int p = tid + 512 * i, key = p >> 4, d8 = (p & 15) * 8;
            const bf16_t* src = P + (size_t)(tokbase + kt * 128 + key) * PLD + 512 + h * 128 + d8;
            const u32x4 kv = *(const u32x4*)src; *(u32x4*)(Ks + key * RLD + d8) = kv;
            const u32x4 vv = *(const u32x4*)(src + 512);
            bf16_t* vd = Vt + d8 * RLD + key;
            vd[0] = (bf16_t)(vv.x & 0xffffu); vd[RLD] = (bf16_t)(vv.x >> 16); vd[2 * RLD] = (bf16_t)(vv.y & 0xffffu); vd[3 * RLD] = (bf16_t)(vv.y >> 16);
            vd[4 * RLD] = (bf16_t)(vv.z & 0xffffu); vd[5 * RLD] = (bf16_t)(vv.z >> 16); vd[6 * RLD] = (bf16_t)(vv.w & 0xffffu); vd[7 * RLD] = (bf16_t)(vv.w >> 16); }
        __syncthreads();
#pragma unroll
        for (int nt = 0; nt < 8; ++nt) { f32x4 s = (f32x4){0.f, 0.f, 0.f, 0.f};
#pragma unroll
            for (int ks = 0; ks < 4; ++ks) { const bf16x8 b = *(const bf16x8*)(Ks + (16 * nt + l15) * RLD + 32 * ks + 8 * lq); s = MFMA16(qf[ks], b, s); }
#pragma unroll
            for (int r = 0; r < 4; ++r) { const int tq = t0 + 16 * w + 4 * lq + r, jk = kt * 128 + 16 * nt + l15, d = tq - jk;
                const float f = d > 0 ? exp2f((float)d * lgf) : (d < 0 ? exp2f((float)(-d) * lgb) : 2.0f);
                Pw[(4 * lq + r) * RLD + 16 * nt + l15] = f2bf(s[r] * f); } }
        __syncthreads();
        bf16x8 pa[4];
#pragma unroll
        for (int ks = 0; ks < 4; ++ks) pa[ks] = *(const bf16x8*)(Pw + l15 * RLD + 32 * ks + 8 * lq);
#pragma unroll
        for (int nd = 0; nd < 8; ++nd)
#pragma unroll
            for (int ks = 0; ks < 4; ++ks) { const bf16x8 b = *(const bf16x8*)(Vt + (16 * nd + l15) * RLD + 32 * ks + 8 * lq); oacc[nd] = MFMA16(pa[ks], b, oacc[nd]); }
    }
    if (bsel >= 0) {
#pragma unroll 1
        for (int dir = 0; dir < 2; ++dir) {
            const float* S0 = a.in[2 + dir] + (size_t)(bsel * 4 + h) * 16384;
            __syncthreads();
#pragma unroll
            for (int i = 0; i < 8; ++i) { const int p = tid + 512 * i, dk = p >> 5, dv4 = (p & 31) * 4;
                const f32x4 v = *(const f32x4*)(S0 + dk * 128 + dv4);
                bf16_t* d = Vt + dv4 * RLD + dk; d[0] = f2bf(v[0]); d[RLD] = f2bf(v[1]); d[2 * RLD] = f2bf(v[2]); d[3 * RLD] = f2bf(v[3]); }
            __syncthreads();
            float fac[4];
#pragma unroll
            for (int r = 0; r < 4; ++r) { const int tq = t0 + 16 * w + 4 * lq + r; fac[r] = dir == 0 ? exp2f((float)(tq + 1) * lgf) : exp2f((float)(L - tq) * lgb); }
#pragma unroll
            for (int nd = 0; nd < 8; ++nd) { f32x4 t = (f32x4){0.f, 0.f, 0.f, 0.f};
#pragma unroll
                for (int ks = 0; ks < 4; ++ks) { const bf16x8 b = *(const bf16x8*)(Vt + (16 * nd + l15) * RLD + 32 * ks + 8 * lq); t = MFMA16(qf[ks], b, t); }
#pragma unroll
                for (int r = 0; r < 4; ++r) oacc[nd][r] += fac[r] * t[r]; }
        }
    }
    bf16_t* R = (bf16_t*)(a.ws + WS_R);
#pragma unroll
    for (int r = 0; r < 4; ++r) {
        float s = 0.f;
#pragma unroll
        for (int nd = 0; nd < 8; ++nd) s += oacc[nd][r];
        s = wsum16(s); const float mu = s * (1.0f / 128.0f);
        float q = 0.f;
#pragma unroll
        for (int nd = 0; nd < 8; ++nd) { const float dlt = oacc[nd][r] - mu; q += dlt * dlt; }
        q = wsum16(q); const float rs = rsqrtf(q * (1.0f / 128.0f) + 1e-6f);
        const size_t tok = (size_t)(tokbase + t0 + 16 * w + 4 * lq + r);
#pragma unroll
        for (int nd = 0; nd < 8; ++nd) { const int dv = 16 * nd + l15;
            const float gv = bf2f(P[tok * PLD + 1536 + h * 128 + dv]);
            R[tok * 512 + h * 128 + dv] = f2bf((oacc[nd][r] - mu) * rs * gv); }
    }
}
__device__ __forceinline__ void state_unit(const Args& a, unsigned char* smem, int b, int h, int dir) {
    bf16_t* Kt = (bf16_t*)smem; bf16_t* Vt = Kt + 128 * SLD;
    const bf16_t* P = (const bf16_t*)(a.ws + WS_P);
    const int tid = threadIdx.x, lane = tid & 63, w = tid >> 6, l15 = lane & 15, lq = lane >> 4;
    const float lg = log2_sigmoid(a.in[11 + dir][h]);
    const int tokbase = b * 256;
    __syncthreads();
#pragma unroll
    for (int i = 0; i < 8; ++i) { const int p = tid + 512 * i, key = p >> 4, d8 = (p & 15) * 8;
        const bf16_t* src = P + (size_t)(tokbase + key) * PLD + 512 + h * 128 + d8;
        const float wg = exp2f((float)(dir == 0 ? 255 - key : key) * lg);
        const u32x4 kv = *(const u32x4*)src; const u32x4 vv = *(const u32x4*)(src + 512);
        bf16_t* kd = Kt + d8 * SLD + key;
        kd[0] = f2bf(bf_lo(kv.x) * wg); kd[SLD] = f2bf(bf_hi(kv.x) * wg); kd[2 * SLD] = f2bf(bf_lo(kv.y) * wg); kd[3 * SLD] = f2bf(bf_hi(kv.y) * wg);
        kd[4 * SLD] = f2bf(bf_lo(kv.z) * wg); kd[5 * SLD] = f2bf(bf_hi(kv.z) * wg); kd[6 * SLD] = f2bf(bf_lo(kv.w) * wg); kd[7 * SLD] = f2bf(bf_hi(kv.w) * wg);
        bf16_t* vd = Vt + d8 * SLD + key;
        vd[0] = (bf16_t)(vv.x & 0xffffu); vd[SLD] = (bf16_t)(vv.x >> 16); vd[2 * SLD] = (bf16_t)(vv.y & 0xffffu); vd[3 * SLD] = (bf16_t)(vv.y >> 16);
        vd[4 * SLD] = (bf16_t)(vv.z & 0xffffu); vd[5 * SLD] = (bf16_t)(vv.z >> 16); vd[6 * SLD] = (bf16_t)(vv.w & 0xffffu); vd[7 * SLD] = (bf16_t)(vv.w >> 16); }
    __syncthreads();
    float* outp = a.out + (size_t)MTOK * DM + (size_t)dir * (32 * 4 * 16384) + (size_t)(b * 4 + h) * 16384;
#pragma unroll
    for (int nd = 0; nd < 8; ++nd) { f32x4 acc = (f32x4){0.f, 0.f, 0.f, 0.f};
#pragma unroll
        for (int ks = 0; ks < 8; ++ks) { const bf16x8 af = *(const bf16x8*)(Kt + (16 * w + l15) * SLD + 32 * ks + 8 * lq);
            const bf16x8 bfr = *(const bf16x8*)(Vt + (16 * nd + l15) * SLD + 32 * ks + 8 * lq); acc = MFMA16(af, bfr, acc); }
#pragma unroll
        for (int r = 0; r < 4; ++r) outp[(16 * w + 4 * lq + r) * 128 + 16 * nd + l15] = acc[r]; }
}
__device__ __forceinline__ float u4_elem(const u32x4& v, int e) { const unsigned w = v[e >> 1]; return (e & 1) ? bf_hi(w) : bf_lo(w); }
__device__ __forceinline__ void hy_unit(const Args& a, unsigned char* smem, int gidx, int cb) {
    bf16_t* U = (bf16_t*)smem;
    float* Fr = (float*)(smem + 49664);
    const bf16_t* P = (const bf16_t*)(a.ws + WS_P);
    const int tid = threadIdx.x, lane = tid & 63, w = tid >> 6;
    const bool isctx = gidx < 8; const int L = isctx ? 256 : 1024, nbl = L >> 5, tokbase = gidx * 1024, c0 = cb * 8;
    __syncthreads();
#pragma unroll 1
    for (int part = 0; part < 3; ++part) { const int colb = part * 512 + c0; const float* cw = a.in[13] + colb; const float* cbs = a.in[14] + colb;
#pragma unroll 1
        for (int it = 0; it < 2; ++it) { const int tok = tid + 512 * it; const int per = isctx ? 256 : 64, tl = tok & (per - 1);
            const bf16_t* src = P + (size_t)(tokbase + tok) * PLD + 2048 + colb;
            const u32x4 cur = *(const u32x4*)src; u32x4 prv = (u32x4){0u, 0u, 0u, 0u}, nxt = (u32x4){0u, 0u, 0u, 0u};
            if (tl != 0) prv = *(const u32x4*)(src - PLD);
            if (tl != per - 1) nxt = *(const u32x4*)(src + PLD);
#pragma unroll
            for (int e = 0; e < 8; ++e) { const float u = cw[e] * u4_elem(prv, e) + cw[1536 + e] * u4_elem(cur, e) + cw[3072 + e] * u4_elem(nxt, e) + cbs[e];
                U[(part * 8 + e) * ULD + tok] = f2bf(u); } } }
    __syncthreads();
    const int c = c0 + w; bf16_t* Uw = U + w * ULD; float* Frw = Fr + w * 2048;
    const int i = lane & 31, hh = lane >> 5;
    const float* FG = (const float*)(a.ws + (isctx ? WS_FG256 : WS_FG1024));
    const float* FPART = (const float*)(a.ws + WS_FPART);
    const int cbase = isctx ? 0 : 16, nch = isctx ? 16 : 64;
#pragma unroll 1
    for (int o = 0; o < 2; ++o) {
        float ps = 0.f;
        if (lane < nch) ps = FPART[(cbase + lane) * 2048 + o * 1024 + c] + FPART[(cbase + lane) * 2048 + o * 1024 + 512 + c];
        ps = wsum64(ps); const float inv = 1.0f / ps;
        const float* fsrc = FG + (size_t)(o * 512 + c) * (2 * L);
        for (int x = lane; x < 2 * L; x += 64) Frw[x] = fsrc[x] * inv;
        __syncthreads();
        f32x16 acc;
#pragma unroll
        for (int q = 0; q < 16; ++q) acc[q] = 0.f;
        const int tb = i & (nbl - 1);
#pragma unroll 1
        for (int d0 = -(nbl - 1); d0 <= nbl - 1; ++d0) {
            const int sb = tb - d0; const bool valid = (sb >= 0) && (sb < nbl);
#pragma unroll
            for (int ks = 0; ks < 2; ++ks) {
                const float* fp = Frw + (L - 1 - 32 * d0 - i + 16 * ks + 8 * hh);
                u32x4 aw; aw.x = cvt_pk_bf16(fp[0], fp[1]); aw.y = cvt_pk_bf16(fp[2], fp[3]); aw.z = cvt_pk_bf16(fp[4], fp[5]); aw.w = cvt_pk_bf16(fp[6], fp[7]);
                const int off = valid ? (32 * (i - d0) + 16 * ks + 8 * hh) : 0;
                u32x4 bw = *(const u32x4*)(Uw + off);
                if (!valid) bw = (u32x4){0u, 0u, 0u, 0u};
                acc = __builtin_amdgcn_mfma_f32_32x32x16_bf16(__builtin_bit_cast(bf16x8, aw), __builtin_bit_cast(bf16x8, bw), acc, 0, 0, 0);
            } }
        const float hb = a.in[21][o * 512 + c];
        const bf16_t* Xm = U + ((1 + o) * 8 + w) * ULD;
#pragma unroll
        for (int g = 0; g < 4; ++g) { const int tok4 = 32 * i + 8 * g + 4 * hh;
            const u32x2 sv = *(const u32x2*)(Uw + tok4); const u32x2 xv = *(const u32x2*)(Xm + tok4);
            const float z0 = bf_lo(xv.x) * (acc[4 * g + 0] + bf_lo(sv.x) * hb), z1 = bf_hi(xv.x) * (acc[4 * g + 1] + bf_hi(sv.x) * hb);
            const float z2 = bf_lo(xv.y) * (acc[4 * g + 2] + bf_lo(sv.y) * hb), z3 = bf_hi(xv.y) * (acc[4 * g + 3] + bf_hi(sv.y) * hb);
            u32x2 zo; zo.x = cvt_pk_bf16(z0, z1); zo.y = cvt_pk_bf16(z2, z3);
            *(u32x2*)(Uw + tok4) = zo; }
        __syncthreads();
    }
    bf16_t* Z = (bf16_t*)(a.ws + WS_Z);
#pragma unroll 1
    for (int it = 0; it < 2; ++it) { const int tok = tid + 512 * it;
        u32x4 wv; wv.x = (unsigned)U[0 * ULD + tok] | ((unsigned)U[1 * ULD + tok] << 16); wv.y = (unsigned)U[2 * ULD + tok] | ((unsigned)U[3 * ULD + tok] << 16);
        wv.z = (unsigned)U[4 * ULD + tok] | ((unsigned)U[5 * ULD + tok] << 16); wv.w = (unsigned)U[6 * ULD + tok] | ((unsigned)U[7 * ULD + tok] << 16);
        *(u32x4*)(Z + (size_t)(tokbase + tok) * 512 + c0) = wv; }
}
#define XB_TMO      128
#define XB_XCNT(j)  (256  + 64 * (j))
#define XB_XSUB(j)  (1280 + 64 * (j))
#define XB_XGEN(j)  (2304 + 64 * (j))
#define XB_TOP      3328
#define XB_TOPGEN   3392
#define XCD_BAR_WORDS 3456
#define XB_SPIN_CAP (1u << 18)
#define LAS __attribute__((address_space(3)))

__device__ __forceinline__ unsigned xb_ld(unsigned* p)              { return __hip_atomic_load(p, __ATOMIC_RELAXED, __HIP_MEMORY_SCOPE_AGENT); }
__device__ __forceinline__ unsigned xb_add(unsigned* p, unsigned v) { return __hip_atomic_fetch_add(p, v, __ATOMIC_RELAXED, __HIP_MEMORY_SCOPE_AGENT); }
__device__ __forceinline__ unsigned xb_xcc_id() { return (unsigned)__builtin_amdgcn_s_getreg((3 << 11) | 20) & 0xFu; }
#define XB_SPIN(cond, bar) do { unsigned _sp = 0; while (cond) { __builtin_amdgcn_s_sleep(1); \
    if ((++_sp & 255u) == 0u) { if (xb_ld(&(bar)[XB_TMO])) break; if (_sp > XB_SPIN_CAP) { atomicAdd(&(bar)[XB_TMO], 1u); break; } } } } while (0)

struct XcdBarrier {
    unsigned* bar; unsigned x;
    volatile LAS unsigned* st;
};

__device__ __forceinline__ XcdBarrier xcd_barrier_post(unsigned* bar, volatile LAS unsigned* st) {
    XcdBarrier b; b.bar = bar; b.x = xb_xcc_id(); b.st = st;
    if (threadIdx.x == 0) (void)xb_add(&bar[XB_XCNT(b.x)], 1u);
    return b;
}
__device__ __forceinline__ void xcd_barrier_complete(unsigned* bar, unsigned x, unsigned& nloc, unsigned& nx) {
    const unsigned G = gridDim.x * gridDim.y * gridDim.z;
    unsigned sum, cnt, mine, sp = 0u;
    for (;;) {
        sum = 0u; cnt = 0u; mine = 0u;
#pragma unroll
        for (unsigned j = 0; j < 16; ++j) { const unsigned c = xb_ld(&bar[XB_XCNT(j)]); sum += c; cnt += (c > 0u) ? 1u : 0u; mine = (j == x) ? c : mine; }
        if (sum == G) break;
        __builtin_amdgcn_s_sleep(1);
        if ((++sp & 255u) == 0u) { if (xb_ld(&bar[XB_TMO])) break; if (sp > XB_SPIN_CAP) { atomicAdd(&bar[XB_TMO], 1u); break; } }
    }
    nloc = mine > 0u ? mine : 1u; nx = cnt > 0u ? cnt : 1u;
}

__device__ __forceinline__ void xcd_barrier(const XcdBarrier& b) {
    asm volatile("s_waitcnt vmcnt(0)" ::: "memory");
    __syncthreads();
    if (threadIdx.x == 0) {
        unsigned* bar = b.bar;
        __builtin_amdgcn_s_waitcnt(0);
        unsigned nloc = b.st[0], nx = b.st[1];
        if (nloc == 0u) { xcd_barrier_complete(bar, b.x, nloc, nx); b.st[0] = nloc; b.st[1] = nx; }
        const unsigned old = xb_add(&bar[XB_XSUB(b.x)], 1u);
        const unsigned gen = old / nloc;
        if (old + 1u == (gen + 1u) * nloc) {
            __builtin_amdgcn_fence(__ATOMIC_RELEASE, "agent");
            asm volatile("s_waitcnt vmcnt(0)" ::: "memory");
            const unsigned og = xb_add(&bar[XB_TOP], 1u);
            const unsigned tg = og / nx;
            if (og + 1u == (tg + 1u) * nx) xb_add(&bar[XB_TOPGEN], 1u);
            else XB_SPIN(xb_ld(&bar[XB_TOPGEN]) == tg, bar);
            __builtin_amdgcn_fence(__ATOMIC_ACQUIRE, "agent");
            xb_add(&bar[XB_XGEN(b.x)], 1u);
            asm volatile("s_waitcnt vmcnt(0)" ::: "memory");
        } else {
            XB_SPIN(xb_ld(&bar[XB_XGEN(b.x)]) == gen, bar);
            __builtin_amdgcn_fence(__ATOMIC_ACQUIRE, "agent");
            asm volatile("s_waitcnt vmcnt(0)" ::: "memory");
        }
    }
    __syncthreads();
}

__global__ void __launch_bounds__(512, 2) mk_fwd(Args a) {
    extern __shared__ __attribute__((aligned(16))) unsigned char smem[];
    cg::grid_group grid = cg::this_grid();
    PG8_LAS unsigned char* lds = (PG8_LAS unsigned char*)smem;
    const int G = gridDim.x, bid = blockIdx.x, tid = threadIdx.x;
    unsigned char* ws = a.ws;
    bf16_t* Wt_in = (bf16_t*)(ws + WS_WIN); bf16_t* Wt_fi = (bf16_t*)(ws + WS_WFI); bf16_t* Wt_fo = (bf16_t*)(ws + WS_WFO);
    bf16_t* Wt_out = (bf16_t*)(ws + WS_WOUT); bf16_t* Wt_ret = (bf16_t*)(ws + WS_WRET); bf16_t* Wt_hy = (bf16_t*)(ws + WS_WHY);
    bf16_t* HB = (bf16_t*)(ws + WS_HB); bf16_t* Pb = (bf16_t*)(ws + WS_P); bf16_t* SG = (bf16_t*)(ws + WS_SG);
    bf16_t* Rb = (bf16_t*)(ws + WS_R); bf16_t* Zb = (bf16_t*)(ws + WS_Z); bf16_t* ACT = (bf16_t*)(ws + WS_ACT);
    const float* MOD = (const float*)(ws + WS_MOD);
    pg8::StaticOrder S;
    const int lo = a.ph_lo, hi = a.ph_hi;
    volatile LAS unsigned* xst = (volatile LAS unsigned*)(lds + LDS_BYTES - 16);
    if (tid < 4) xst[tid] = 0u;
    __syncthreads();
    XcdBarrier bar; bar.bar = (unsigned*)ws; bar.x = 0; bar.st = xst;
    if (hi - lo > 1) bar = xcd_barrier_post((unsigned*)ws, xst);
    if (lo > 1000) grid.sync();
#ifdef ONLY_PHASE
#define IN(k) ((k) == ONLY_PHASE && lo <= (k) && (k) < hi)
#else
#define IN(k) (lo <= (k) && (k) < hi)
#endif
#define SEAM(k) do { if (lo <= (k) && (k) + 1 < hi) { xcd_barrier(bar); } } while (0)
    {
        if (IN(0)) {
            for (int t = bid; t < 352 + 4032; t += G) {
                if (t < 192) ph0_ada(a, t, (float*)smem);
                else if (t < 352) ph0_hidden(a, t - 192, (float*)smem);
                else { int q = t - 352;
                    if (q < 1408) ph0_wtile(a.in[10], Wt_in, 1024, NIN, q / 88, q % 88, false, (float*)smem);
                    else if ((q -= 1408) < 1408) ph0_wtile(a.in[25], Wt_fi, 1024, NIN, q / 88, q % 88, true, (float*)smem);
                    else if ((q -= 1408) < 704) ph0_wtile(a.in[26], Wt_fo, DFF, 1024, q / 16, q % 16, false, (float*)smem);
                    else if ((q -= 704) < 256) ph0_wtile(a.in[24], Wt_out, 1024, 1024, q / 16, q % 16, false, (float*)smem);
                    else if ((q -= 256) < 128) ph0_wtile(a.in[22], Wt_ret, 512, 1024, q / 16, q % 16, false, (float*)smem);
                    else { q -= 128; ph0_wtile(a.in[23], Wt_hy, 512, 1024, q / 16, q % 16, false, (float*)smem); } }
            }
        }
        SEAM(0);
        if (IN(1)) {
            for (int t = bid; t < 320; t += G) ph1_taps(a, t);
            norm_mod_rows(a, a.in[0], a.in[1], a.in[6], 0, 1024, HB);
        }
        SEAM(1);
        if (IN(2)) {
            pg8::Gemm g{HB, Wt_in, MTOK, NIN, 1024}; S.init(MTOK, NIN, G, bid); EpiInProj E{Pb, SG};
            pg8::gemm_phase<EpiInProj, pg8::StaticOrder>(lds, g, S, E, nullptr);
        }
        SEAM(2);
        if (IN(3)) {
            for (int u = bid; u < 1408; u += G) {
                if (u < 256) hy_unit(a, smem, 8 + (u >> 6), u & 63);
                else if (u < 384) { const int q = u - 256; ret_unit(a, smem, NCTX + (q >> 5) * 1024, 1024, q >> 5, (q >> 3) & 3, q & 7); }
                else if (u < 896) { const int q = u - 384; hy_unit(a, smem, q >> 6, q & 63); }
                else if (u < 1152) { const int q = u - 896; ret_unit(a, smem, (q >> 3) * 256, 256, -1, (q >> 1) & 3, q & 1); }
                else { const int q = u - 1152; state_unit(a, smem, q >> 3, (q >> 1) & 3, q & 1); }
            }
            __syncthreads();
        }
        SEAM(3);
        if (IN(4)) {
            S.init(MTOK, 1024, G, bid);
            { pg8::Gemm g{Rb, Wt_ret, MTOK, 1024, 512}; EpiGateT1 E{a.out, SG}; pg8::gemm_phase<EpiGateT1, pg8::StaticOrder>(lds, g, S, E, nullptr); }
            { pg8::Gemm g{Zb, Wt_hy, MTOK, 1024, 512}; EpiMix E{a.out, SG, HB}; pg8::gemm_phase<EpiMix, pg8::StaticOrder>(lds, g, S, E, nullptr); }
        }
        SEAM(4);
        if (IN(5)) {
            pg8::Gemm g{HB, Wt_out, MTOK, 1024, 1024}; S.init(MTOK, 1024, G, bid); EpiRes E{a.in[0], a.in[1], MOD + 2048, a.out};
            pg8::gemm_phase<EpiRes, pg8::StaticOrder>(lds, g, S, E, nullptr);
        }
        SEAM(5);
        if (IN(6)) {
            norm_mod_rows(a, a.out, a.out + (size_t)NCTX * DM, a.in[7], 3072, 4096, HB);
        }
        SEAM(6);
        if (IN(7)) {
            pg8::Gemm g{HB, Wt_fi, MTOK, NIN, 1024}; S.init(MTOK, NIN, G, bid); EpiSwiglu E{ACT};
            pg8::gemm_phase<EpiSwiglu, pg8::StaticOrder>(lds, g, S, E, nullptr);
        }
        SEAM(7);
        if (IN(8)) {
            pg8::Gemm g{ACT, Wt_fo, MTOK, 1024, DFF}; S.init(MTOK, 1024, G, bid); EpiRes E{a.out, a.out + (size_t)NCTX * DM, MOD + 5120, a.out};
            pg8::gemm_phase<EpiRes, pg8::StaticOrder>(lds, g, S, E, nullptr);
        }
        SEAM(8);
        if (IN(9)) {
            const int lane = tid & 63, w = tid >> 6; const float* fg = a.in[27];
            for (int row = bid * 8 + w; row < MTOK; row += G * 8) { float* xr = a.out + (size_t)row * DM;
                f32x4 v[4]; float ss = 0.f;
#pragma unroll
                for (int i = 0; i < 4; ++i) { v[i] = *(const f32x4*)(xr + i * 256 + lane * 4); ss += v[i][0] * v[i][0] + v[i][1] * v[i][1] + v[i][2] * v[i][2] + v[i][3] * v[i][3]; }
                ss = wsum64(ss); const float rstd = rsqrtf(ss * (1.0f / 1024.0f) + 1e-6f);
#pragma unroll
                for (int i = 0; i < 4; ++i) { const f32x4 g = *(const f32x4*)(fg + i * 256 + lane * 4); *(f32x4*)(xr + i * 256 + lane * 4) = v[i] * rstd * g; } }
        }
    }
}

extern "C" void kernel_launch(void* const* d_in, const int* in_sizes, int n_in, void* d_out, int out_size, void* d_ws, size_t ws_size, hipStream_t stream) {
    static int grid = 0;
    if (grid == 0) {
        if (n_in != 28 || in_sizes[0] != NCTX * DM || out_size != MTOK * DM + 2 * 32 * 4 * 16384 || ws_size < WS_END) {
            fprintf(stderr, "kernel_launch: unexpected shapes (n_in %d, in0 %d, out %d, ws %zu); nothing launched\n", n_in, n_in > 0 ? in_sizes[0] : -1, out_size, ws_size); grid = -1; return; }
        int dev = 0, cus = 0, per_cu = 0;
        if (hipGetDevice(&dev) != hipSuccess || hipDeviceGetAttribute(&cus, hipDeviceAttributeMultiprocessorCount, dev) != hipSuccess) { grid = -1; return; }
        if (hipFuncSetAttribute((const void*)mk_fwd, hipFuncAttributeMaxDynamicSharedMemorySize, LDS_BYTES) != hipSuccess) { fprintf(stderr, "kernel_launch: hipFuncSetAttribute failed\n"); grid = -1; return; }
        if (hipOccupancyMaxActiveBlocksPerMultiprocessor(&per_cu, (const void*)mk_fwd, 512, LDS_BYTES) != hipSuccess || per_cu < 1) { fprintf(stderr, "kernel_launch: occupancy query says %d\n", per_cu); per_cu = 1; }
        (void)hipGetLastError();
        grid = cus * 1;
    }
    if (grid < 0) return;
    Args a{};
    for (int i = 0; i < 28; ++i) a.in[i] = (const float*)d_in[i];
    a.out = (float*)d_out; a.ws = (unsigned char*)d_ws;
#if MK_ONE_LAUNCH
    if (hipMemsetAsync(d_ws, 0, 16384, stream) != hipSuccess) { fprintf(stderr, "kernel_launch: memset failed\n"); return; }
    a.ph_lo = 0; a.ph_hi = N_PHASES;
    void* args[] = {&a};
    hipError_t e = hipLaunchCooperativeKernel((const void*)mk_fwd, dim3(grid), dim3(512), args, LDS_BYTES, stream);
    if (e != hipSuccess) fprintf(stderr, "kernel_launch: cooperative launch failed: %s (grid %d)\n", hipGetErrorString(e), grid);
#else
    for (int ph = 0; ph < N_PHASES; ++ph) { a.ph_lo = ph; a.ph_hi = ph + 1;
        hipLaunchKernelGGL(mk_fwd, dim3(grid), dim3(512), LDS_BYTES, stream, a); }
#endif
}
```

```cpp
#include <hip/hip_runtime.h>
#include <hip/hip_cooperative_groups.h>
#include <cstdio>
#include <cstdint>
namespace cg = cooperative_groups;
namespace pg8 {
#define PG8_LAS __attribute__((address_space(3)))
typedef unsigned short bf16_t;
typedef short bf16x8 __attribute__((ext_vector_type(8)));
typedef float f32x4 __attribute__((ext_vector_type(4)));
typedef unsigned u32x4 __attribute__((ext_vector_type(4)));
constexpr int BM = 256, BK = 64, HALF = 128, HTB = HALF * BK * 2  , STAGE_BYTES = 8 * HTB, NXCD = 8, WGM = 8;

__host__ __device__ __forceinline__ int lds_byte(int r, int c) { const int st = (r >> 4) * 2 + (c >> 5), rr = r & 15, cc = c & 31, ob = rr * 64 + cc * 2; return st * 1024 + (ob ^ (((ob >> 9) & 1) << 5)); }
__host__ __device__ __forceinline__ void stage_rc(int b, int& R, int& C) { const int st = b / 1024, sb = b % 1024, swz = sb ^ (((sb >> 9) & 1) << 5); R = (st >> 1) * 16 + swz / 64; C = (st & 1) * 32 + (swz % 64) / 2; }
__host__ __device__ __forceinline__ int perm32(int rho) { const int n = rho >> 4, i = rho & 15; return 8 * (i >> 2) + 4 * n + (i & 3); }

struct Unit { int pm, pn; };
struct Gemm { const bf16_t* A; const bf16_t* Bt; int M, N, K; };

struct StaticOrder {
    int nM, nN, nwg, G, c;
    __host__ __device__ void init(int M, int N, int G_, int c_) { nM = M / BM; nN = N / BM; nwg = nM * nN; G = G_; c = c_; }
    __host__ __device__ bool next(int i, Unit& u) const {
        const long L = (long)i * G + c; if (L >= nwg) return false;
        int wgid = (int)L; { const int q = nwg / NXCD, r = nwg % NXCD, xcd = wgid % NXCD, off = wgid / NXCD; wgid = (xcd < r ? xcd * (q + 1) : r * (q + 1) + (xcd - r) * q) + off; }
        const int nig = WGM * nN, gid = wgid / nig, fm = gid * WGM, gsz = (nM - fm) < WGM ? (nM - fm) : WGM;
        u.pm = fm + ((wgid % nig) % gsz); u.pn = (wgid % nig) / gsz; return true;
    }
    __device__ __forceinline__ void a_ready(const Unit&) const {}
    __device__ __forceinline__ void done(const Unit&) const {}
};
__device__ __forceinline__ unsigned cvt_pk_bf16(float lo, float hi) { unsigned r; asm volatile("v_cvt_pk_bf16_f32 %0, %1, %2" : "=v"(r) : "v"(lo), "v"(hi)); return r; }

template <class Epi, class Sched, bool STAMP = false>
__device__ __forceinline__ void gemm_phase(PG8_LAS unsigned char* lds, const Gemm g, const Sched& S, const Epi& E, unsigned long long* stamps) {
    const int tid = threadIdx.x, wid = __builtin_amdgcn_readfirstlane(tid >> 6), lane = tid & 63, wr = wid >> 2, wc = wid & 3, fr = lane & 15, fq = lane >> 4;
    const int K = g.K, nt = K / BK;
    int ts_lo = 0, ts_hi = 0, nts = 0; const unsigned long long rt_entry = STAMP ? (unsigned long long)wall_clock64() : 0ull;
#define PG8_STAMP() do { if (STAMP && wid == 0 && nts < 64) { const unsigned long long _c = (unsigned long long)clock64(); \
        ts_lo = (lane == nts) ? (int)(unsigned)_c : ts_lo; ts_hi = (lane == nts) ? (int)(unsigned)(_c >> 32) : ts_hi; ++nts; } } while (0)
    PG8_STAMP();
    unsigned voffA[2], voffB[2];
#pragma unroll
    for (int i = 0; i < 2; ++i) { int R, C; stage_rc(tid * 16 + i * 8192, R, C); const int Rb = Epi::PERM ? ((R & ~31) + perm32(R & 31)) : R;
        voffA[i] = (unsigned)(R * K + C) * 2u; voffB[i] = (unsigned)(Rb * K + C) * 2u; }
    const size_t kstep = (size_t)(BK * 2);
    const size_t hstep = (size_t)HALF * K * 2;
    const size_t tstep = 2 * hstep;
    const unsigned ldsw = (unsigned)wid * 1024u;
    const int aoff = lds_byte(wr * 64 + fr, fq * 8), boff = lds_byte(wc * 32 + fr, fq * 8);
#define PG8_SA(b, h) (((b) * 2 + (h)) * HTB)
#define PG8_SB(b, h) ((4 + (b) * 2 + (h)) * HTB)
#define PG8_STAGE(bufoff, gbase, voff) do { _Pragma("unroll") for (int _i = 0; _i < 2; ++_i) \
        __builtin_amdgcn_global_load_lds((const unsigned*)((const char*)(gbase) + (voff)[_i]), (PG8_LAS unsigned*)(lds + (bufoff) + ldsw + _i * 8192), 16, 0, 0); } while (0)
#define PG8_LDA(dst, b, h) do { _Pragma("unroll") for (int m = 0; m < 4; ++m) _Pragma("unroll") for (int k = 0; k < 2; ++k) dst[m][k] = *(const PG8_LAS bf16x8*)(lds + PG8_SA(b, h) + aoff + m * 2048 + k * 1024); } while (0)
#define PG8_LDB(dst, b, h) do { _Pragma("unroll") for (int n = 0; n < 2; ++n) _Pragma("unroll") for (int k = 0; k < 2; ++k) dst[n][k] = *(const PG8_LAS bf16x8*)(lds + PG8_SB(b, h) + boff + n * 2048 + k * 1024); } while (0)
#define PG8_MMA(ai, bj, At, Bt) do { __builtin_amdgcn_s_setprio(1); _Pragma("unroll") for (int m = 0; m < 4; ++m) _Pragma("unroll") for (int n = 0; n < 2; ++n) _Pragma("unroll") for (int k = 0; k < 2; ++k) \
        acc[ai][bj][m][n] = __builtin_amdgcn_mfma_f32_16x16x32_bf16(Bt[n][k], At[m][k], acc[ai][bj][m][n], 0, 0, 0); __builtin_amdgcn_s_setprio(0); } while (0)
#define PG8_WAIT_V(n) asm volatile("s_waitcnt vmcnt(" #n ")" ::: "memory")
#define PG8_WAIT_L(n) asm volatile("s_waitcnt lgkmcnt(" #n ")" ::: "memory")
#define PG8_BAR __builtin_amdgcn_s_barrier()
#define PG8_SCHED __builtin_amdgcn_sched_barrier(0)
    Unit cur, nxt; int ui = 0;
    if (!S.next(0, cur)) return;
    f32x4 acc[2][2][4][2];
#pragma unroll
    for (int a = 0; a < 2; ++a)
#pragma unroll
        for (int b = 0; b < 2; ++b)
#pragma unroll
            for (int m = 0; m < 4; ++m)
#pragma unroll
                for (int n = 0; n < 2; ++n) acc[a][b][m][n] = (f32x4){0.f, 0.f, 0.f, 0.f};
    bf16x8 At[4][2], B0[2][2], B1[2][2];
    const char* cA = (const char*)g.A + (size_t)cur.pm * tstep; const char* cB = (const char*)g.Bt + (size_t)cur.pn * tstep;
    S.a_ready(cur);
    PG8_STAGE(PG8_SB(0, 0), cB, voffB); PG8_STAGE(PG8_SA(0, 0), cA, voffA); PG8_STAGE(PG8_SB(0, 1), cB + hstep, voffB); PG8_STAGE(PG8_SA(0, 1), cA + hstep, voffA);
    if (wr == 1) PG8_BAR;
    PG8_WAIT_V(4); PG8_BAR;
    PG8_STAGE(PG8_SB(1, 0), cB + kstep, voffB); PG8_STAGE(PG8_SA(1, 0), cA + kstep, voffA); PG8_STAGE(PG8_SB(1, 1), cB + hstep + kstep, voffB);
    PG8_WAIT_V(6); PG8_BAR;
    PG8_STAMP();
    for (;;) {
        const bool has_next = S.next(ui + 1, nxt);
        const char* nA = has_next ? (const char*)g.A + (size_t)nxt.pm * tstep : cA; const char* nB = has_next ? (const char*)g.Bt + (size_t)nxt.pn * tstep : cB;
        for (int t = 0; t < nt; t += 2) {
            const bool last = (t == nt - 2);
            const char* a1 = cA + (size_t)(t + 1) * kstep;
            const char* a2 = last ? nA : cA + (size_t)(t + 2) * kstep; const char* b2 = last ? nB : cB + (size_t)(t + 2) * kstep;
            const char* a3 = a2 + kstep; const char* b3 = b2 + kstep;
            if (last && has_next) S.a_ready(nxt);
            PG8_LDB(B0, 0, 0); PG8_SCHED; PG8_LDA(At, 0, 0); PG8_STAGE(PG8_SA(1, 1), a1 + hstep, voffA);
            PG8_WAIT_L(8); PG8_BAR; PG8_WAIT_L(0); PG8_MMA(0, 0, At, B0); PG8_BAR; PG8_SCHED;
            PG8_LDB(B1, 0, 1); PG8_STAGE(PG8_SB(0, 0), b2, voffB);
            PG8_BAR; PG8_WAIT_L(0); PG8_MMA(0, 1, At, B1); PG8_BAR;
            PG8_LDA(At, 0, 1); PG8_STAGE(PG8_SA(0, 0), a2, voffA);
            PG8_BAR; PG8_WAIT_L(0); PG8_MMA(1, 0, At, B0); PG8_BAR; PG8_SCHED;
            PG8_STAGE(PG8_SB(0, 1), b2 + hstep, voffB);
            PG8_WAIT_V(6); PG8_BAR; PG8_MMA(1, 1, At, B1); PG8_BAR;
            PG8_LDB(B0, 1, 0); PG8_SCHED; PG8_LDA(At, 1, 0); PG8_STAGE(PG8_SA(0, 1), a2 + hstep, voffA);
            PG8_WAIT_L(8); PG8_BAR; PG8_WAIT_L(0); PG8_MMA(0, 0, At, B0); PG8_BAR; PG8_SCHED;
            PG8_LDB(B1, 1, 1); PG8_STAGE(PG8_SB(1, 0), b3, voffB);
            PG8_BAR; PG8_WAIT_L(0); PG8_MMA(0, 1, At, B1); PG8_BAR;
            PG8_LDA(At, 1, 1); PG8_STAGE(PG8_SA(1, 0), a3, voffA);
            PG8_BAR; PG8_WAIT_L(0); PG8_MMA(1, 0, At, B0); PG8_BAR; PG8_SCHED;
            PG8_STAGE(PG8_SB(1, 1), b3 + hstep, voffB);
            PG8_WAIT_V(6); PG8_BAR; PG8_MMA(1, 1, At, B1); PG8_BAR;
        }
        PG8_STAMP();
        if constexpr (!Epi::AFTER_DRAIN) { E(acc, cur, wr, wc, fr, fq); S.done(cur); }
        PG8_STAMP();
        if (!has_next) break;
#pragma unroll
        for (int a = 0; a < 2; ++a)
#pragma unroll
            for (int b = 0; b < 2; ++b)
#pragma unroll
                for (int m = 0; m < 4; ++m)
#pragma unroll
                    for (int n = 0; n < 2; ++n) acc[a][b][m][n] = (f32x4){0.f, 0.f, 0.f, 0.f};
        cur = nxt; cA = nA; cB = nB; ++ui;
    }
    PG8_WAIT_V(0);
    if (wr == 0) PG8_BAR;
    PG8_BAR;
    if constexpr (Epi::AFTER_DRAIN) { E.fused(acc, cur, wr, wc, fr, fq, lds, wid, lane); S.done(cur); }
    PG8_STAMP();
    if (STAMP && wid == 0) { stamps[lane] = lane < nts ? (((unsigned long long)(unsigned)ts_hi << 32) | (unsigned)ts_lo) : 0ull;
        if (lane == 62) stamps[62] = rt_entry; if (lane == 63) stamps[63] = (unsigned long long)wall_clock64(); }
#undef PG8_STAMP
#undef PG8_SA
#undef PG8_SB
#undef PG8_STAGE
#undef PG8_LDA
#undef PG8_LDB
#undef PG8_MMA
#undef PG8_WAIT_V
#undef PG8_WAIT_L
#undef PG8_BAR
#undef PG8_SCHED
}
}

using pg8::bf16_t; using pg8::bf16x8; using pg8::f32x4; using pg8::u32x4; using pg8::Unit; using pg8::cvt_pk_bf16;
typedef float f32x16 __attribute__((ext_vector_type(16)));
typedef unsigned u32x2 __attribute__((ext_vector_type(2)));

#ifndef MK_ONE_LAUNCH
#define MK_ONE_LAUNCH 1
#endif

constexpr int DM = 1024, NCTX = 8192, MTOK = 12288, NIN = 5632, DFF = 2816, PLD = 3584, SGLD = 2048, NMOD = 6144;
constexpr int N_PHASES = 10;
constexpr size_t MiB = 1u << 20;
constexpr size_t WS_MOD = 1 * MiB, WS_H2F = WS_MOD + 128 * 1024, WS_FPART = WS_MOD + 512 * 1024;
constexpr size_t WS_WIN = 3 * MiB, WS_WFI = 15 * MiB, WS_WFO = 26 * MiB, WS_WOUT = 32 * MiB, WS_WRET = 34 * MiB, WS_WHY = 35 * MiB;
constexpr size_t WS_FG256 = 36 * MiB, WS_FG1024 = 38 * MiB, WS_HB = 46 * MiB, WS_R = 70 * MiB, WS_Z = 82 * MiB, WS_SG = 94 * MiB, WS_P1 = 142 * MiB, WS_PT = 178 * MiB, WS_ACT = 142 * MiB, WS_END = 238 * MiB;
constexpr int LDS_BYTES = 147456;

struct Args { const float* in[28]; float* out; unsigned char* ws; int ph_lo, ph_hi; };

__device__ __forceinline__ float bf_lo(unsigned w) { return __uint_as_float(w << 16); }
__device__ __forceinline__ float bf_hi(unsigned w) { return __uint_as_float(w & 0xffff0000u); }
__device__ __forceinline__ float bf2f(bf16_t b) { return __uint_as_float(((unsigned)b) << 16); }
__device__ __forceinline__ bf16_t f2bf(float f) { return (bf16_t)(cvt_pk_bf16(f, 0.0f) & 0xffffu); }
__device__ __forceinline__ float wsum16(float v) { v += __shfl_xor(v, 1); v += __shfl_xor(v, 2); v += __shfl_xor(v, 4); v += __shfl_xor(v, 8); return v; }
__device__ __forceinline__ float wsum64(float v) { v = wsum16(v); v += __shfl_xor(v, 16); v += __shfl_xor(v, 32); return v; }
__device__ __forceinline__ float log2_sigmoid(float x) { return -log1pf(expf(-x)) * 1.4426950408889634f; }
__device__ __forceinline__ int row_group(int row) { return row < NCTX ? 0 : 1 + ((row - NCTX) >> 10); }

__device__ __forceinline__ float act_apply(float v, int mode) {
    if (mode == 0) return v;
    if (mode == 1) return v * 0.08838834764831845f;
    const float s = 1.0f / (1.0f + __expf(-v));
    return mode == 2 ? v * s : s;
}
struct EpiMain {
    static constexpr bool PERM = true, AFTER_DRAIN = false;
    bf16_t* P1; bf16_t* SG;
    __device__ __forceinline__ void operator()(const f32x4 (&acc)[2][2][4][2], const Unit& u, int wr, int wc, int fr, int fq) const {
        const int row0 = u.pm * 256 + wr * 64 + fr, pn = u.pn;
        bf16_t* base; int ldc, colt, mode;
        if (pn < 6) { base = P1; ldc = 1536; colt = pn * 256; mode = pn >> 1; }
        else { base = SG; ldc = SGLD; colt = pn * 256 - 1536; mode = 3; }
        const int col0 = colt + wc * 32 + 8 * fq;
#pragma unroll
        for (int ai = 0; ai < 2; ++ai)
#pragma unroll
            for (int m = 0; m < 4; ++m) { bf16_t* rowp = base + (size_t)(row0 + ai * 128 + m * 16) * ldc + col0;
#pragma unroll
                for (int bj = 0; bj < 2; ++bj) { const f32x4 v0 = acc[ai][bj][m][0], v1 = acc[ai][bj][m][1];
                    u32x4 w; w.x = cvt_pk_bf16(act_apply(v0[0], mode), act_apply(v0[1], mode)); w.y = cvt_pk_bf16(act_apply(v0[2], mode), act_apply(v0[3], mode));
                    w.z = cvt_pk_bf16(act_apply(v1[0], mode), act_apply(v1[1], mode)); w.w = cvt_pk_bf16(act_apply(v1[2], mode), act_apply(v1[3], mode));
                    *(u32x4*)(rowp + bj * 128) = w; } }
    }
};
struct EpiT {
    static constexpr bool PERM = true, AFTER_DRAIN = false;
    bf16_t* PT;
    __device__ __forceinline__ void operator()(const f32x4 (&acc)[2][2][4][2], const Unit& u, int wr, int wc, int fr, int fq) const {
        const int row0 = u.pm * 256 + wr * 64 + fr, col0 = u.pn * 256 + wc * 32 + 8 * fq;
        const float sc = (u.pm == 2 || u.pm == 3) ? 0.08838834764831845f : 1.0f;
#pragma unroll
        for (int ai = 0; ai < 2; ++ai)
#pragma unroll
            for (int m = 0; m < 4; ++m) { bf16_t* rowp = PT + (size_t)(row0 + ai * 128 + m * 16) * MTOK + col0;
#pragma unroll
                for (int bj = 0; bj < 2; ++bj) { const f32x4 v0 = acc[ai][bj][m][0] * sc, v1 = acc[ai][bj][m][1] * sc;
                    u32x4 w; w.x = cvt_pk_bf16(v0[0], v0[1]); w.y = cvt_pk_bf16(v0[2], v0[3]); w.z = cvt_pk_bf16(v1[0], v1[1]); w.w = cvt_pk_bf16(v1[2], v1[3]);
                    *(u32x4*)(rowp + bj * 128) = w; } }
    }
};
struct EpiGateT1 {
    static constexpr bool PERM = false, AFTER_DRAIN = false;
    float* T1; const bf16_t* SG;
    __device__ __forceinline__ void operator()(const f32x4 (&acc)[2][2][4][2], const Unit& u, int wr, int wc, int fr, int fq) const {
        const int row0 = u.pm * 256 + wr * 64 + fr, col0 = u.pn * 256 + wc * 32 + 4 * fq;
#pragma unroll
        for (int ai = 0; ai < 2; ++ai)
#pragma unroll
            for (int m = 0; m < 4; ++m) { const int row = row0 + ai * 128 + m * 16;
#pragma unroll
                for (int bj = 0; bj < 2; ++bj)
#pragma unroll
                    for (int n = 0; n < 2; ++n) { const int col = col0 + bj * 128 + n * 16;
                        const u32x2 g = *(const u32x2*)(SG + (size_t)row * SGLD + col);
                        const f32x4 gv = {bf_lo(g.x), bf_hi(g.x), bf_lo(g.y), bf_hi(g.y)};
                        *(f32x4*)(T1 + (size_t)row * DM + col) = acc[ai][bj][m][n] * gv; }
                asm volatile("" ::: "memory"); }
    }
};
struct EpiMix {
    static constexpr bool PERM = false, AFTER_DRAIN = false;
    const float* T1; const bf16_t* SG; bf16_t* MIX;
    __device__ __forceinline__ void operator()(const f32x4 (&acc)[2][2][4][2], const Unit& u, int wr, int wc, int fr, int fq) const {
        const int row0 = u.pm * 256 + wr * 64 + fr, col0 = u.pn * 256 + wc * 32 + 4 * fq;
#pragma unroll
        for (int ai = 0; ai < 2; ++ai)
#pragma unroll
            for (int m = 0; m < 4; ++m) { const int row = row0 + ai * 128 + m * 16;
#pragma unroll
                for (int bj = 0; bj < 2; ++bj)
#pragma unroll
                    for (int n = 0; n < 2; ++n) { const int col = col0 + bj * 128 + n * 16;
                        const u32x2 g = *(const u32x2*)(SG + (size_t)row * SGLD + 1024 + col);
                        const f32x4 gv = {bf_lo(g.x), bf_hi(g.x), bf_lo(g.y), bf_hi(g.y)};
                        const f32x4 t = *(const f32x4*)(T1 + (size_t)row * DM + col);
                        const f32x4 r = t + acc[ai][bj][m][n] * gv;
                        u32x2 o; o.x = cvt_pk_bf16(r[0], r[1]); o.y = cvt_pk_bf16(r[2], r[3]);
                        *(u32x2*)(MIX + (size_t)row * DM + col) = o; }
                asm volatile("" ::: "memory"); }
    }
};
struct EpiRes {
    static constexpr bool PERM = false, AFTER_DRAIN = false;
    const float* b0; const float* b1;
    const float* gate;
    float* OUT;
    __device__ __forceinline__ void operator()(const f32x4 (&acc)[2][2][4][2], const Unit& u, int wr, int wc, int fr, int fq) const {
        const int row0 = u.pm * 256 + wr * 64 + fr, col0 = u.pn * 256 + wc * 32 + 4 * fq;
        const int grp = u.pm < 32 ? 0 : 1 + ((u.pm - 32) >> 2);
        const float* gp = gate + grp * NMOD + col0;
        f32x4 gv[2][2];
#pragma unroll
        for (int bj = 0; bj < 2; ++bj)
#pragma unroll
            for (int n = 0; n < 2; ++n) gv[bj][n] = *(const f32x4*)(gp + bj * 128 + n * 16);
#pragma unroll
        for (int ai = 0; ai < 2; ++ai)
#pragma unroll
            for (int m = 0; m < 4; ++m) { const int row = row0 + ai * 128 + m * 16;
                const float* bp = (u.pm < 32 ? b0 + (size_t)row * DM : b1 + (size_t)(row - NCTX) * DM) + col0;
                float* op = OUT + (size_t)row * DM + col0;
#pragma unroll
                for (int bj = 0; bj < 2; ++bj)
#pragma unroll
                    for (int n = 0; n < 2; ++n) { const f32x4 b = *(const f32x4*)(bp + bj * 128 + n * 16);
                        *(f32x4*)(op + bj * 128 + n * 16) = b + gv[bj][n] * acc[ai][bj][m][n]; } }
    }
};
struct EpiSwiglu {
    static constexpr bool PERM = true, AFTER_DRAIN = false;
    bf16_t* ACT;
    __device__ __forceinline__ void operator()(const f32x4 (&acc)[2][2][4][2], const Unit& u, int wr, int wc, int fr, int fq) const {
        const int row0 = u.pm * 256 + wr * 64 + fr, col0 = u.pn * 128 + wc * 32 + 8 * fq;
#pragma unroll
        for (int ai = 0; ai < 2; ++ai)
#pragma unroll
            for (int m = 0; m < 4; ++m) { bf16_t* rowp = ACT + (size_t)(row0 + ai * 128 + m * 16) * DFF + col0;
                float r[8];
#pragma unroll
                for (int n = 0; n < 2; ++n)
#pragma unroll
                    for (int j = 0; j < 4; ++j) { const float av = acc[ai][0][m][n][j], bv = acc[ai][1][m][n][j]; r[n * 4 + j] = av / (1.0f + __expf(-av)) * bv; }
                u32x4 w; w.x = cvt_pk_bf16(r[0], r[1]); w.y = cvt_pk_bf16(r[2], r[3]); w.z = cvt_pk_bf16(r[4], r[5]); w.w = cvt_pk_bf16(r[6], r[7]);
                *(u32x4*)rowp = w; }
    }
};

__device__ __forceinline__ void ph0_ada(const Args& a, int task, float* sm) {
    const int tid = threadIdx.x;
    float* sc = sm; float* red = sm + 5120;
    for (int i = tid; i < 5120; i += 512) { const int g = i >> 10, k = i & 1023; const float v = g == 0 ? a.in[5][k] : a.in[4][(g - 1) * 1024 + k]; sc[i] = v / (1.0f + expf(-v)); }
    __syncthreads();
    const int nl = tid & 31, kg = tid >> 5, n = task * 32 + nl;
    float a0 = 0.f, a1 = 0.f, a2 = 0.f, a3 = 0.f, a4 = 0.f;
    const float* w = a.in[8] + (size_t)(kg * 64) * NMOD + n;
#pragma unroll
    for (int k = 0; k < 64; ++k) { const float wv = w[(size_t)k * NMOD]; const int kk = kg * 64 + k;
        a0 += sc[kk] * wv; a1 += sc[1024 + kk] * wv; a2 += sc[2048 + kk] * wv; a3 += sc[3072 + kk] * wv; a4 += sc[4096 + kk] * wv; }
    red[(kg * 5 + 0) * 32 + nl] = a0; red[(kg * 5 + 1) * 32 + nl] = a1; red[(kg * 5 + 2) * 32 + nl] = a2; red[(kg * 5 + 3) * 32 + nl] = a3; red[(kg * 5 + 4) * 32 + nl] = a4;
    __syncthreads();
    if (tid < 160) { const int g = tid >> 5, l = tid & 31; float s = a.in[9][task * 32 + l];
        for (int q = 0; q < 16; ++q) s += red[(q * 5 + g) * 32 + l];
        ((float*)(a.ws + WS_MOD))[g * NMOD + task * 32 + l] = s; }
    __syncthreads();
}
__device__ __forceinline__ void ph0_hidden(const Args& a, int task, float* sm) {
    float* zf = sm; float* h1s = sm + 320;
    const int tid = threadIdx.x, rr = tid >> 6, j = tid & 63, r = task * 8 + rr;
    const int L = r < 256 ? 256 : 1024, t = r < 256 ? r : r - 256;
    if (j < 33) { float v;
        if (j == 0) v = (float)t / (float)(L - 1);
        else { const int b = (j - 1) & 15; const float band = 1e-4f + (float)b * ((15.0f - 1e-4f) / 15.0f); const float ang = 6.283185307179586f * (float)t / (float)L;
            v = j <= 16 ? cosf(band * ang) : -sinf(band * ang); }
        zf[rr * 40 + j] = v; }
    __syncthreads();
    const float fq = a.in[20][j];
    float s = a.in[16][j];
    for (int e = 0; e < 33; ++e) s += zf[rr * 40 + e] * a.in[15][e * 64 + j];
    h1s[rr * 64 + j] = sinf(fq * s);
    __syncthreads();
    float s2 = a.in[18][j];
    for (int k = 0; k < 64; ++k) s2 += h1s[rr * 64 + k] * a.in[17][k * 64 + j];
    ((float*)(a.ws + WS_H2F))[r * 64 + j] = sinf(fq * s2);
    __syncthreads();
}
__device__ __forceinline__ void ph0_wtile(const float* W, bf16_t* Wt, int K, int N, int kt, int nt, int rowmap, float* sm) {
    const int tid = threadIdx.x;
    { const int k = tid >> 3, n8 = (tid & 7) * 8; const float* src = W + (size_t)(kt * 64 + k) * N + nt * 256 + n8;
      f32x4 v[8];
#pragma unroll
      for (int q = 0; q < 4; ++q) { v[2 * q] = *(const f32x4*)(src + q * 64); v[2 * q + 1] = *(const f32x4*)(src + q * 64 + 4); }
#pragma unroll
      for (int q = 0; q < 4; ++q) { float* d = sm + k * 257 + q * 64 + n8;
        d[0] = v[2 * q][0]; d[1] = v[2 * q][1]; d[2] = v[2 * q][2]; d[3] = v[2 * q][3]; d[4] = v[2 * q + 1][0]; d[5] = v[2 * q + 1][1]; d[6] = v[2 * q + 1][2]; d[7] = v[2 * q + 1][3]; } }
    __syncthreads();
    { const int n = tid & 255, kh = tid >> 8; const float* s = sm + (kh * 32) * 257 + n;
      u32x4 w[4];
#pragma unroll
      for (int q = 0; q < 4; ++q) { const float* sq = s + q * 8 * 257;
        w[q].x = cvt_pk_bf16(sq[0], sq[257]); w[q].y = cvt_pk_bf16(sq[2 * 257], sq[3 * 257]); w[q].z = cvt_pk_bf16(sq[4 * 257], sq[5 * 257]); w[q].w = cvt_pk_bf16(sq[6 * 257], sq[7 * 257]); }
      const int nn = nt * 256 + n; int r0 = nn, r1 = -1;
      if (rowmap == 1) r0 = nn < DFF ? ((nn >> 7) * 256 + (nn & 127)) : (((nn - DFF) >> 7) * 256 + 128 + ((nn - DFF) & 127));
      else if (rowmap == 2) {
          if (nn < 512) r0 = nn;
          else if (nn < 1024) { r0 = nn; r1 = 3584 + 512 + (nn - 512); }
          else if (nn < 1536) r0 = 3584 + (nn - 1024);
          else if (nn < 2048) r0 = 1024 + (nn - 1536);
          else if (nn < 3584) r0 = 3584 + 1024 + (nn - 2048);
          else r0 = 1536 + (nn - 3584); }
      bf16_t* d0 = Wt + (size_t)r0 * K + kt * 64 + kh * 32;
#pragma unroll
      for (int q = 0; q < 4; ++q) *(u32x4*)(d0 + q * 8) = w[q];
      if (r1 >= 0) { bf16_t* d1 = Wt + (size_t)r1 * K + kt * 64 + kh * 32;
#pragma unroll
        for (int q = 0; q < 4; ++q) *(u32x4*)(d1 + q * 8) = w[q]; } }
    __syncthreads();
}
__device__ __forceinline__ void ph1_taps(const Args& a, int task, float* sm) {
    const int ch = task >> 2, cb = task & 3, col = cb * 512 + (int)threadIdx.x;
    const bool small = ch < 16; const int L = small ? 256 : 1024, t0 = small ? ch * 16 : (ch - 16) * 16, rowbase = small ? 0 : 256;
    float w3c[64];
#pragma unroll
    for (int k = 0; k < 64; ++k) w3c[k] = a.in[19][k * 2048 + col];
    const int o = col >> 10, dir = (col >> 9) & 1, cch = col & 511;
    const float dmin = -3.0701134573253945f, dmax = -15.350567286626973f;
    const float delta = fabsf(dmin + (float)cch * ((dmax - dmin) / 511.0f));
    float* fg = (float*)(a.ws + (small ? WS_FG256 : WS_FG1024)) + (size_t)(o * 512 + cch) * (2 * L);
    const float* h2 = (const float*)(a.ws + WS_H2F) + (size_t)(rowbase + t0) * 64;
    __syncthreads();
    sm[threadIdx.x] = h2[threadIdx.x]; sm[512 + threadIdx.x] = h2[512 + threadIdx.x];
    __syncthreads();
    float psum = 0.f;
#pragma unroll 2
    for (int tt = 0; tt < 16; ++tt) { const int t = t0 + tt; const float* hr = sm + tt * 64;
        float s = 0.f;
#pragma unroll
        for (int k = 0; k < 64; ++k) s += hr[k] * w3c[k];
        const float v = s * expf(-((float)t / (float)(L - 1)) * delta);
        if (dir == 0) { fg[L - 1 - t] = v; psum += fabsf(v); }
        else if (t >= 1) { fg[L - 1 + t] = v; psum += fabsf(v); } }
    if (dir == 1 && t0 == 0) fg[2 * L - 1] = 0.f;
    ((float*)(a.ws + WS_FPART))[ch * 2048 + col] = psum;
}
__device__ __forceinline__ void norm_mod_rows(const Args& a, const float* s0, const float* s1, const float* gw, int shoff, int scoff, bf16_t* dst) {
    const int lane = threadIdx.x & 63, w = threadIdx.x >> 6;
    const float* MOD = (const float*)(a.ws + WS_MOD);
    for (int row = blockIdx.x * 8 + w; row < MTOK; row += gridDim.x * 8) {
        const float* xr = row < NCTX ? s0 + (size_t)row * DM : s1 + (size_t)(row - NCTX) * DM;
        const float* mg = MOD + row_group(row) * NMOD;
        f32x4 v[4]; float ss = 0.f;
#pragma unroll
        for (int i = 0; i < 4; ++i) { v[i] = *(const f32x4*)(xr + i * 256 + lane * 4); ss += v[i][0] * v[i][0] + v[i][1] * v[i][1] + v[i][2] * v[i][2] + v[i][3] * v[i][3]; }
        ss = wsum64(ss);
        const float rstd = rsqrtf(ss * (1.0f / 1024.0f) + 1e-6f);
#pragma unroll
        for (int i = 0; i < 4; ++i) { const int c = i * 256 + lane * 4;
            const f32x4 g = *(const f32x4*)(gw + c), sc = *(const f32x4*)(mg + scoff + c), sh = *(const f32x4*)(mg + shoff + c);
            const f32x4 y = v[i] * rstd * g * (sc + 1.0f) + sh;
            u32x2 o; o.x = cvt_pk_bf16(y[0], y[1]); o.y = cvt_pk_bf16(y[2], y[3]);
            *(u32x2*)(dst + (size_t)row * DM + c) = o; }
    }
}
constexpr int RLD = 136, SLD = 264, ULD = 1032, P1LD = 1536;
#define MFMA16(a_, b_, c_) __builtin_amdgcn_mfma_f32_16x16x32_bf16((a_), (b_), (c_), 0, 0, 0)
__device__ __forceinline__ float ex2(float x) { return __builtin_amdgcn_exp2f(x); }
__device__ __forceinline__ void ret_unit(const Args& a, unsigned char* smem, int tokbase, int L, int bsel, int h, int qt) {
    bf16_t* Ks = (bf16_t*)smem; bf16_t* Vt = Ks + 128 * RLD;
    const bf16_t* P1 = (const bf16_t*)(a.ws + WS_P1); const bf16_t* PT = (const bf16_t*)(a.ws + WS_PT);
    const int tid = threadIdx.x, lane = tid & 63, w = tid >> 6, l15 = lane & 15, lq = lane >> 4;
    const float lgf = log2_sigmoid(a.in[11][h]), lgb = log2_sigmoid(a.in[12][h]);
    const int t0 = qt * 128, tq = t0 + 16 * w + l15;
    bf16x8 qf[4];
    { const bf16_t* qp = P1 + (size_t)(tokbase + tq) * P1LD + h * 128 + 8 * lq;
#pragma unroll
      for (int ks = 0; ks < 4; ++ks) qf[ks] = *(const bf16x8*)(qp + 32 * ks); }
    f32x4 oacc[8];
#pragma unroll
    for (int nd = 0; nd < 8; ++nd) oacc[nd] = (f32x4){0.f, 0.f, 0.f, 0.f};
    const int nkt = L >> 7;
    u32x4 kreg[4], vreg[4];
#pragma unroll
    for (int i = 0; i < 4; ++i) { const int p = tid + 512 * i, r = p >> 4, c8 = (p & 15) * 8;
        kreg[i] = *(const u32x4*)(P1 + (size_t)(tokbase + r) * P1LD + 512 + h * 128 + c8);
        vreg[i] = *(const u32x4*)(PT + (size_t)(h * 128 + r) * MTOK + tokbase + c8); }
#pragma unroll 1
    for (int kt = 0; kt < nkt; ++kt) {
        __syncthreads();
#pragma unroll
        for (int i = 0; i < 4; ++i) { const int p = tid + 512 * i, r = p >> 4, c8 = (p & 15) * 8;
            *(u32x4*)(Ks + r * RLD + c8) = kreg[i]; *(u32x4*)(Vt + r * RLD + c8) = vreg[i]; }
        __syncthreads();
        if (kt + 1 < nkt) {
#pragma unroll
            for (int i = 0; i < 4; ++i) { const int p = tid + 512 * i, r = p >> 4, c8 = (p & 15) * 8;
                kreg[i] = *(const u32x4*)(P1 + (size_t)(tokbase + (kt + 1) * 128 + r) * P1LD + 512 + h * 128 + c8);
                vreg[i] = *(const u32x4*)(PT + (size_t)(h * 128 + r) * MTOK + tokbase + (kt + 1) * 128 + c8); } }
#pragma unroll
        for (int kp = 0; kp < 4; ++kp) {
            f32x4 s0 = (f32x4){0.f, 0.f, 0.f, 0.f}, s1 = (f32x4){0.f, 0.f, 0.f, 0.f};
#pragma unroll
            for (int ks = 0; ks < 4; ++ks) {
                const bf16x8 k0 = *(const bf16x8*)(Ks + (32 * kp + l15) * RLD + 32 * ks + 8 * lq);
                const bf16x8 k1 = *(const bf16x8*)(Ks + (32 * kp + 16 + l15) * RLD + 32 * ks + 8 * lq);
                s0 = MFMA16(k0, qf[ks], s0); s1 = MFMA16(k1, qf[ks], s1); }
            float p[8];
#pragma unroll
            for (int r = 0; r < 4; ++r) {
                const int d0 = tq - (kt * 128 + 32 * kp + 4 * lq + r), d1 = d0 - 16;
                const float f0 = d0 > 0 ? ex2((float)d0 * lgf) : (d0 < 0 ? ex2((float)(-d0) * lgb) : 2.0f);
                const float f1 = d1 > 0 ? ex2((float)d1 * lgf) : (d1 < 0 ? ex2((float)(-d1) * lgb) : 2.0f);
                p[r] = s0[r] * f0; p[4 + r] = s1[r] * f1; }
            u32x4 pw; pw.x = cvt_pk_bf16(p[0], p[1]); pw.y = cvt_pk_bf16(p[2], p[3]); pw.z = cvt_pk_bf16(p[4], p[5]); pw.w = cvt_pk_bf16(p[6], p[7]);
            const bf16x8 pb = __builtin_bit_cast(bf16x8, pw);
#pragma unroll
            for (int nd = 0; nd < 8; ++nd) { const bf16_t* vr = Vt + (16 * nd + l15) * RLD + 32 * kp + 4 * lq;
                const u32x2 lo = *(const u32x2*)vr, hi = *(const u32x2*)(vr + 16);
                const u32x4 av = {lo.x, lo.y, hi.x, hi.y};
                oacc[nd] = MFMA16(__builtin_bit_cast(bf16x8, av), pb, oacc[nd]); }
        }
    }
    if (bsel >= 0) {
#pragma unroll 1
        for (int dir = 0; dir < 2; ++dir) {
            const float* S0 = a.in[2 + dir] + (size_t)(bsel * 4 + h) * 16384;
            __syncthreads();
#pragma unroll
            for (int i = 0; i < 8; ++i) { const int p = tid + 512 * i, dk = p & 127, dv4 = (p >> 7) * 4;
                const f32x4 v = *(const f32x4*)(S0 + dk * 128 + dv4);
                bf16_t* d = Vt + dv4 * RLD + dk; d[0] = f2bf(v[0]); d[RLD] = f2bf(v[1]); d[2 * RLD] = f2bf(v[2]); d[3 * RLD] = f2bf(v[3]); }
            __syncthreads();
            const float fac = dir == 0 ? ex2((float)(tq + 1) * lgf) : ex2((float)(L - tq) * lgb);
#pragma unroll
            for (int nd = 0; nd < 8; ++nd) { f32x4 t = (f32x4){0.f, 0.f, 0.f, 0.f};
#pragma unroll
                for (int ks = 0; ks < 4; ++ks) { const bf16x8 sf = *(const bf16x8*)(Vt + (16 * nd + l15) * RLD + 32 * ks + 8 * lq); t = MFMA16(sf, qf[ks], t); }
                oacc[nd] += t * fac; }
        }
    }
    float s = 0.f;
#pragma unroll
    for (int nd = 0; nd < 8; ++nd) s += (oacc[nd][0] + oacc[nd][1]) + (oacc[nd][2] + oacc[nd][3]);
    s += __shfl_xor(s, 16); s += __shfl_xor(s, 32);
    const float mu = s * (1.0f / 128.0f);
    float q2 = 0.f;
#pragma unroll
    for (int nd = 0; nd < 8; ++nd) { const f32x4 d = oacc[nd] - mu; q2 += (d[0] * d[0] + d[1] * d[1]) + (d[2] * d[2] + d[3] * d[3]); }
    q2 += __shfl_xor(q2, 16); q2 += __shfl_xor(q2, 32);
    const float rs = rsqrtf(q2 * (1.0f / 128.0f) + 1e-6f);
    bf16_t* R = (bf16_t*)(a.ws + WS_R);
    const size_t tok = (size_t)(tokbase + tq);
#pragma unroll
    for (int nd = 0; nd < 8; ++nd) { const int dv4 = 16 * nd + 4 * lq;
        const u32x2 g = *(const u32x2*)(P1 + tok * P1LD + 1024 + h * 128 + dv4);
        const f32x4 y = (oacc[nd] - mu) * rs;
        u32x2 o; o.x = cvt_pk_bf16(y[0] * bf_lo(g.x), y[1] * bf_hi(g.x)); o.y = cvt_pk_bf16(y[2] * bf_lo(g.y), y[3] * bf_hi(g.y));
        *(u32x2*)(R + tok * 512 + h * 128 + dv4) = o; }
}
__device__ __forceinline__ void state_unit(const Args& a, unsigned char* smem, int b, int h, int dir) {
    bf16_t* Kt = (bf16_t*)smem; bf16_t* Vt = Kt + 128 * SLD;
    const bf16_t* PT = (const bf16_t*)(a.ws + WS_PT);
    const int tid = threadIdx.x, lane = tid & 63, w = tid >> 6, l15 = lane & 15, lq = lane >> 4;
    const float lg = log2_sigmoid(a.in[11 + dir][h]);
    const int tokbase = b * 256;
    __syncthreads();
#pragma unroll
    for (int i = 0; i < 8; ++i) { const int p = tid + 512 * i, r = p >> 5, k8 = (p & 31) * 8;
        const u32x4 kv = *(const u32x4*)(PT + (size_t)(512 + h * 128 + r) * MTOK + tokbase + k8);
        const int e0 = dir == 0 ? 255 - k8 : k8, st = dir == 0 ? -1 : 1;
        u32x4 ko;
        ko.x = cvt_pk_bf16(bf_lo(kv.x) * ex2((float)(e0) * lg), bf_hi(kv.x) * ex2((float)(e0 + st) * lg));
        ko.y = cvt_pk_bf16(bf_lo(kv.y) * ex2((float)(e0 + 2 * st) * lg), bf_hi(kv.y) * ex2((float)(e0 + 3 * st) * lg));
        ko.z = cvt_pk_bf16(bf_lo(kv.z) * ex2((float)(e0 + 4 * st) * lg), bf_hi(kv.z) * ex2((float)(e0 + 5 * st) * lg));
        ko.w = cvt_pk_bf16(bf_lo(kv.w) * ex2((float)(e0 + 6 * st) * lg), bf_hi(kv.w) * ex2((float)(e0 + 7 * st) * lg));
        *(u32x4*)(Kt + r * SLD + k8) = ko;
        *(u32x4*)(Vt + r * SLD + k8) = *(const u32x4*)(PT + (size_t)(h * 128 + r) * MTOK + tokbase + k8); }
    __syncthreads();
    float* outp = a.out + (size_t)MTOK * DM + (size_t)dir * (32 * 4 * 16384) + (size_t)(b * 4 + h) * 16384;
    bf16x8 af[8];
#pragma unroll
    for (int ks = 0; ks < 8; ++ks) af[ks] = *(const bf16x8*)(Kt + (16 * w + l15) * SLD + 32 * ks + 8 * lq);
#pragma unroll
    for (int nd = 0; nd < 8; ++nd) { f32x4 acc = (f32x4){0.f, 0.f, 0.f, 0.f};
#pragma unroll
        for (int ks = 0; ks < 8; ++ks) { const bf16x8 bfr = *(const bf16x8*)(Vt + (16 * nd + l15) * SLD + 32 * ks + 8 * lq); acc = MFMA16(af[ks], bfr, acc); }
#pragma unroll
        for (int r = 0; r < 4; ++r) outp[(16 * w + 4 * lq + r) * 128 + 16 * nd + l15] = acc[r]; }
}
__device__ __forceinline__ void hy_load_taps(const float* fsrc, int L, int lane, f32x4 (&fv)[8], float (&fx)[8]) {
#pragma unroll
    for (int j = 0; j < 8; ++j) { const int x = lane * 4 + 256 * j;
        fv[j] = x < 2 * L ? *(const f32x4*)(fsrc + x) : (f32x4){0.f, 0.f, 0.f, 0.f};
        fx[j] = x + 4 < 2 * L ? fsrc[x + 4] : 0.f; }
}
__device__ __forceinline__ void hy_unit(const Args& a, unsigned char* smem, int gidx, int cb) {
    bf16_t* U = (bf16_t*)smem;
    unsigned* Fr = (unsigned*)(smem + 49664);
    const bf16_t* PT = (const bf16_t*)(a.ws + WS_PT);
    const int tid = threadIdx.x, lane = tid & 63, w = tid >> 6;
    const bool isctx = gidx < 8; const int L = isctx ? 256 : 1024, nbl = L >> 5, tokbase = gidx * 1024, c0 = cb * 8;
    const int c = c0 + w;
    const float* FG = (const float*)(a.ws + (isctx ? WS_FG256 : WS_FG1024));
    const float* FPART = (const float*)(a.ws + WS_FPART);
    const int cbase = isctx ? 0 : 16, nch = isctx ? 16 : 64, per = isctx ? 256 : 64;
    u32x4 cur[6]; unsigned short xmb[6], xpb[6];
#pragma unroll
    for (int i = 0; i < 6; ++i) { const int idx = tid + 512 * i, chl = idx >> 7, t8 = (idx & 127) * 8, col = (chl >> 3) * 512 + c0 + (chl & 7);
        const bf16_t* src = PT + (size_t)(1024 + col) * MTOK + tokbase + t8; const int tl = t8 & (per - 1);
        cur[i] = *(const u32x4*)src; xmb[i] = tl != 0 ? src[-1] : (unsigned short)0; xpb[i] = (tl + 8 != per) ? src[8] : (unsigned short)0; }
    float ps0 = 0.f, ps1 = 0.f;
    if (lane < nch) { const float* fp = FPART + (cbase + lane) * 2048 + c; ps0 = fp[0] + fp[512]; ps1 = fp[1024] + fp[1536]; }
    f32x4 fv[8]; float fx[8];
    hy_load_taps(FG + (size_t)c * (2 * L), L, lane, fv, fx);
    __syncthreads();
#pragma unroll
    for (int i = 0; i < 6; ++i) { const int idx = tid + 512 * i, chl = idx >> 7, t8 = (idx & 127) * 8, col = (chl >> 3) * 512 + c0 + (chl & 7);
        const float xm = bf2f(xmb[i]), xp = bf2f(xpb[i]);
        const float w0 = a.in[13][col], w1 = a.in[13][1536 + col], w2 = a.in[13][3072 + col], bb = a.in[14][col];
        const float x0 = bf_lo(cur[i].x), x1 = bf_hi(cur[i].x), x2 = bf_lo(cur[i].y), x3 = bf_hi(cur[i].y), x4 = bf_lo(cur[i].z), x5 = bf_hi(cur[i].z), x6 = bf_lo(cur[i].w), x7 = bf_hi(cur[i].w);
        u32x4 o;
        o.x = cvt_pk_bf16(w0 * xm + w1 * x0 + w2 * x1 + bb, w0 * x0 + w1 * x1 + w2 * x2 + bb);
        o.y = cvt_pk_bf16(w0 * x1 + w1 * x2 + w2 * x3 + bb, w0 * x2 + w1 * x3 + w2 * x4 + bb);
        o.z = cvt_pk_bf16(w0 * x3 + w1 * x4 + w2 * x5 + bb, w0 * x4 + w1 * x5 + w2 * x6 + bb);
        o.w = cvt_pk_bf16(w0 * x5 + w1 * x6 + w2 * x7 + bb, w0 * x6 + w1 * x7 + w2 * xp + bb);
        *(u32x4*)(U + chl * ULD + t8) = o; }
    bf16_t* Uw = U + w * ULD; unsigned* Frw = Fr + w * 2048;
    const int i = lane & 31, hh = lane >> 5, tb = i & (nbl - 1);
    ps0 = wsum64(ps0); ps1 = wsum64(ps1);
#pragma unroll 1
    for (int o = 0; o < 2; ++o) {
        const float inv = 1.0f / (o == 0 ? ps0 : ps1);
#pragma unroll
        for (int j = 0; j < 8; ++j) { const int x = lane * 4 + 256 * j;
            if (x < 2 * L) { const f32x4 v = fv[j] * inv; const float v4 = fx[j] * inv;
                u32x2 ev, ov; ev.x = cvt_pk_bf16(v[0], v[1]); ev.y = cvt_pk_bf16(v[2], v[3]); ov.x = cvt_pk_bf16(v[1], v[2]); ov.y = cvt_pk_bf16(v[3], v4);
                *(u32x2*)(Frw + (x >> 1)) = ev; *(u32x2*)(Frw + L + (x >> 1)) = ov; } }
        if (o == 0) hy_load_taps(FG + (size_t)(512 + c) * (2 * L), L, lane, fv, fx);
        __syncthreads();
        f32x16 acc;
#pragma unroll
        for (int q = 0; q < 16; ++q) acc[q] = 0.f;
#pragma unroll 1
        for (int d0 = -(nbl - 1); d0 <= nbl - 1; ++d0) {
            const int sb = tb - d0; const bool valid = (sb >= 0) && (sb < nbl);
#pragma unroll
            for (int ks = 0; ks < 2; ++ks) {
                const int xs = L - 1 - 32 * d0 - i + 16 * ks + 8 * hh;
                const unsigned* fp = Frw + (xs >> 1) + ((xs & 1) ? L : 0);
                u32x4 aw; aw.x = fp[0]; aw.y = fp[1]; aw.z = fp[2]; aw.w = fp[3];
                const int off = valid ? (32 * (i - d0) + 16 * ks + 8 * hh) : 0;
                u32x4 bw = *(const u32x4*)(Uw + off);
                if (!valid) bw = (u32x4){0u, 0u, 0u, 0u};
                acc = __builtin_amdgcn_mfma_f32_32x32x16_bf16(__builtin_bit_cast(bf16x8, aw), __builtin_bit_cast(bf16x8, bw), acc, 0, 0, 0);
            } }
        const float hb = a.in[21][o * 512 + c];
        const bf16_t* Xm = U + ((1 + o) * 8 + w) * ULD;
#pragma unroll
        for (int g = 0; g < 4; ++g) { const int tok4 = 32 * i + 8 * g + 4 * hh;
            const u32x2 sv = *(const u32x2*)(Uw + tok4); const u32x2 xv = *(const u32x2*)(Xm + tok4);
            const float z0 = bf_lo(xv.x) * (acc[4 * g + 0] + bf_lo(sv.x) * hb), z1 = bf_hi(xv.x) * (acc[4 * g + 1] + bf_hi(sv.x) * hb);
            const float z2 = bf_lo(xv.y) * (acc[4 * g + 2] + bf_lo(sv.y) * hb), z3 = bf_hi(xv.y) * (acc[4 * g + 3] + bf_hi(sv.y) * hb);
            u32x2 zo; zo.x = cvt_pk_bf16(z0, z1); zo.y = cvt_pk_bf16(z2, z3);
            *(u32x2*)(Uw + tok4) = zo; }
        __syncthreads();
    }
    bf16_t* Z = (bf16_t*)(a.ws + WS_Z);
#pragma unroll 1
    for (int it = 0; it < 2; ++it) { const int tok = tid + 512 * it;
        u32x4 wv; wv.x = (unsigned)U[0 * ULD + tok] | ((unsigned)U[1 * ULD + tok] << 16); wv.y = (unsigned)U[2 * ULD + tok] | ((unsigned)U[3 * ULD + tok] << 16);
        wv.z = (unsigned)U[4 * ULD + tok] | ((unsigned)U[5 * ULD + tok] << 16); wv.w = (unsigned)U[6 * ULD + tok] | ((unsigned)U[7 * ULD + tok] << 16);
        *(u32x4*)(Z + (size_t)(tokbase + tok) * 512 + c0) = wv; }
}
#define XB_TMO      128
#define XB_XCNT(j)  (256  + 64 * (j))
#define XB_XSUB(j)  (1280 + 64 * (j))
#define XB_XGEN(j)  (2304 + 64 * (j))
#define XB_TOP      3328
#define XB_TOPGEN   3392
#define XCD_BAR_WORDS 3456
#define XB_SPIN_CAP (1u << 18)
#define LAS __attribute__((address_space(3)))

__device__ __forceinline__ unsigned xb_ld(unsigned* p)              { return __hip_atomic_load(p, __ATOMIC_RELAXED, __HIP_MEMORY_SCOPE_AGENT); }
__device__ __forceinline__ unsigned xb_add(unsigned* p, unsigned v) { return __hip_atomic_fetch_add(p, v, __ATOMIC_RELAXED, __HIP_MEMORY_SCOPE_AGENT); }
__device__ __forceinline__ unsigned xb_xcc_id() { return (unsigned)__builtin_amdgcn_s_getreg((3 << 11) | 20) & 0xFu; }
#define XB_SPIN(cond, bar) do { unsigned _sp = 0; while (cond) { __builtin_amdgcn_s_sleep(1); \
    if ((++_sp & 255u) == 0u) { if (xb_ld(&(bar)[XB_TMO])) break; if (_sp > XB_SPIN_CAP) { atomicAdd(&(bar)[XB_TMO], 1u); break; } } } } while (0)

struct XcdBarrier {
    unsigned* bar; unsigned x;
    volatile LAS unsigned* st;
};

__device__ __forceinline__ XcdBarrier xcd_barrier_post(unsigned* bar, volatile LAS unsigned* st) {
    XcdBarrier b; b.bar = bar; b.x = xb_xcc_id(); b.st = st;
    if (threadIdx.x == 0) (void)xb_add(&bar[XB_XCNT(b.x)], 1u);
    return b;
}
__device__ __forceinline__ void xcd_barrier_complete(unsigned* bar, unsigned x, unsigned& nloc, unsigned& nx) {
    const unsigned G = gridDim.x * gridDim.y * gridDim.z;
    unsigned sum, cnt, mine, sp = 0u;
    for (;;) {
        sum = 0u; cnt = 0u; mine = 0u;
#pragma unroll
        for (unsigned j = 0; j < 16; ++j) { const unsigned c = xb_ld(&bar[XB_XCNT(j)]); sum += c; cnt += (c > 0u) ? 1u : 0u; mine = (j == x) ? c : mine; }
        if (sum == G) break;
        __builtin_amdgcn_s_sleep(1);
        if ((++sp & 255u) == 0u) { if (xb_ld(&bar[XB_TMO])) break; if (sp > XB_SPIN_CAP) { atomicAdd(&bar[XB_TMO], 1u); break; } }
    }
    nloc = mine > 0u ? mine : 1u; nx = cnt > 0u ? cnt : 1u;
}

__device__ __forceinline__ void xcd_barrier(const XcdBarrier& b) {
    asm volatile("s_waitcnt vmcnt(0)" ::: "memory");
    __syncthreads();
    if (threadIdx.x == 0) {
        unsigned* bar = b.bar;
        __builtin_amdgcn_s_waitcnt(0);
        unsigned nloc = b.st[0], nx = b.st[1];
        if (nloc == 0u) { xcd_barrier_complete(bar, b.x, nloc, nx); b.st[0] = nloc; b.st[1] = nx; }
        const unsigned old = xb_add(&bar[XB_XSUB(b.x)], 1u);
        const unsigned gen = old / nloc;
        if (old + 1u == (gen + 1u) * nloc) {
            __builtin_amdgcn_fence(__ATOMIC_RELEASE, "agent");
            asm volatile("s_waitcnt vmcnt(0)" ::: "memory");
            const unsigned og = xb_add(&bar[XB_TOP], 1u);
            const unsigned tg = og / nx;
            if (og + 1u == (tg + 1u) * nx) xb_add(&bar[XB_TOPGEN], 1u);
            else XB_SPIN(xb_ld(&bar[XB_TOPGEN]) == tg, bar);
            __builtin_amdgcn_fence(__ATOMIC_ACQUIRE, "agent");
            xb_add(&bar[XB_XGEN(b.x)], 1u);
            asm volatile("s_waitcnt vmcnt(0)" ::: "memory");
        } else {
            XB_SPIN(xb_ld(&bar[XB_XGEN(b.x)]) == gen, bar);
            __builtin_amdgcn_fence(__ATOMIC_ACQUIRE, "agent");
            asm volatile("s_waitcnt vmcnt(0)" ::: "memory");
        }
    }
    __syncthreads();
}

__global__ void __launch_bounds__(512, 2) mk_fwd(Args a) {
    extern __shared__ __attribute__((aligned(16))) unsigned char smem[];
    cg::grid_group grid = cg::this_grid();
    PG8_LAS unsigned char* lds = (PG8_LAS unsigned char*)smem;
    const int G = gridDim.x, bid = blockIdx.x, tid = threadIdx.x;
    unsigned char* ws = a.ws;
    bf16_t* Wt_in = (bf16_t*)(ws + WS_WIN); bf16_t* Wt_fi = (bf16_t*)(ws + WS_WFI); bf16_t* Wt_fo = (bf16_t*)(ws + WS_WFO);
    bf16_t* Wt_out = (bf16_t*)(ws + WS_WOUT); bf16_t* Wt_ret = (bf16_t*)(ws + WS_WRET); bf16_t* Wt_hy = (bf16_t*)(ws + WS_WHY);
    bf16_t* HB = (bf16_t*)(ws + WS_HB); bf16_t* P1b = (bf16_t*)(ws + WS_P1); bf16_t* PTb = (bf16_t*)(ws + WS_PT); bf16_t* SG = (bf16_t*)(ws + WS_SG);
    bf16_t* Rb = (bf16_t*)(ws + WS_R); bf16_t* Zb = (bf16_t*)(ws + WS_Z); bf16_t* ACT = (bf16_t*)(ws + WS_ACT);
    const float* MOD = (const float*)(ws + WS_MOD);
    pg8::StaticOrder S;
    const int lo = a.ph_lo, hi = a.ph_hi;
    volatile LAS unsigned* xst = (volatile LAS unsigned*)(lds + LDS_BYTES - 16);
    if (tid < 4) xst[tid] = 0u;
    __syncthreads();
    XcdBarrier bar; bar.bar = (unsigned*)ws; bar.x = 0; bar.st = xst;
    if (hi - lo > 1) bar = xcd_barrier_post((unsigned*)ws, xst);
    if (lo > 1000) grid.sync();
#ifdef ONLY_PHASE
#define IN(k) ((k) == ONLY_PHASE && lo <= (k) && (k) < hi)
#else
#define IN(k) (lo <= (k) && (k) < hi)
#endif
#ifndef PROBE_MASK
#define PROBE_MASK 0
#endif
#define NREP(k) ((((PROBE_MASK) >> (k)) & 1) + 1)
#define SEAM(k) do { if (lo <= (k) && (k) + 1 < hi) { xcd_barrier(bar); } } while (0)
    {
        if (IN(0)) for (int rp = 0; rp < NREP(0); ++rp) { if (rp) xcd_barrier(bar);
            for (int t = bid; t < 352 + 1008; t += G) {
                if (t < 192) ph0_ada(a, t, (float*)smem);
                else if (t < 352) ph0_hidden(a, t - 192, (float*)smem);
                else { int q = t - 352;
                    if (q < 352) ph0_wtile(a.in[10], Wt_in, 1024, NIN, q / 22, q % 22, 2, (float*)smem);
                    else if ((q -= 352) < 352) ph0_wtile(a.in[25], Wt_fi, 1024, NIN, q / 22, q % 22, 1, (float*)smem);
                    else if ((q -= 352) < 176) ph0_wtile(a.in[26], Wt_fo, DFF, 1024, q / 4, q % 4, 0, (float*)smem);
                    else if ((q -= 176) < 64) ph0_wtile(a.in[24], Wt_out, 1024, 1024, q / 4, q % 4, 0, (float*)smem);
                    else if ((q -= 64) < 32) ph0_wtile(a.in[22], Wt_ret, 512, 1024, q / 4, q % 4, 0, (float*)smem);
                    else { q -= 32; ph0_wtile(a.in[23], Wt_hy, 512, 1024, q / 4, q % 4, 0, (float*)smem); } }
            }
        }
        SEAM(0);
        if (IN(1)) for (int rp = 0; rp < NREP(1); ++rp) { if (rp) xcd_barrier(bar);
            for (int t = bid; t < 320; t += G) ph1_taps(a, t, (float*)smem);
            norm_mod_rows(a, a.in[0], a.in[1], a.in[6], 0, 1024, HB);
        }
        SEAM(1);
        if (IN(2)) for (int rp = 0; rp < NREP(2); ++rp) { if (rp) xcd_barrier(bar);
            { pg8::Gemm g{HB, Wt_in, MTOK, 3584, 1024}; S.init(MTOK, 3584, G, bid); EpiMain E{P1b, SG}; pg8::gemm_phase<EpiMain, pg8::StaticOrder>(lds, g, S, E, nullptr); }
            { pg8::Gemm g{Wt_in + (size_t)3584 * 1024, HB, 2560, MTOK, 1024}; S.init(2560, MTOK, G, (bid + 96) % G); EpiT E{PTb}; pg8::gemm_phase<EpiT, pg8::StaticOrder>(lds, g, S, E, nullptr); }
        }
        SEAM(2);
        if (IN(3)) for (int rp = 0; rp < NREP(3); ++rp) { if (rp) xcd_barrier(bar);
            const int nu = (G == 256) ? 6 : (1408 + G - 1) / G;
            for (int it = 0; it < nu; ++it) {
                int u;
                if (G == 256) {
                    if (it == 0) u = bid;
                    else if (bid < 128) { if (it == 1) u = 256 + bid; else if (it == 2) u = 384 + bid; else if (it == 3) u = 896 + bid; else if (it == 4) u = 1152 + bid; else u = -1; }
                    else { if (it <= 3) u = 384 + 128 + 3 * (bid - 128) + (it - 1); else if (it == 4) u = 896 + bid; else u = 1152 + bid; }
                } else { u = bid + it * G; if (u >= 1408) u = -1; }
                if (u < 0) continue;
                if (u < 256) hy_unit(a, smem, 8 + (u >> 6), u & 63);
                else if (u < 384) { const int q = u - 256; ret_unit(a, smem, NCTX + (q >> 5) * 1024, 1024, q >> 5, (q >> 3) & 3, q & 7); }
                else if (u < 896) { const int q = u - 384; hy_unit(a, smem, q >> 6, q & 63); }
                else if (u < 1152) { const int q = u - 896; ret_unit(a, smem, (q >> 3) * 256, 256, -1, (q >> 1) & 3, q & 1); }
                else { const int q = u - 1152; state_unit(a, smem, q >> 3, (q >> 1) & 3, q & 1); }
            }
            __syncthreads();
        }
        SEAM(3);
        if (IN(4)) for (int rp = 0; rp < NREP(4); ++rp) { if (rp) xcd_barrier(bar);
            S.init(MTOK, 1024, G, bid);
            { pg8::Gemm g{Rb, Wt_ret, MTOK, 1024, 512}; EpiGateT1 E{a.out, SG}; pg8::gemm_phase<EpiGateT1, pg8::StaticOrder>(lds, g, S, E, nullptr); }
            { pg8::Gemm g{Zb, Wt_hy, MTOK, 1024, 512}; EpiMix E{a.out, SG, HB}; pg8::gemm_phase<EpiMix, pg8::StaticOrder>(lds, g, S, E, nullptr); }
        }
        SEAM(4);
        if (IN(5)) for (int rp = 0; rp < NREP(5); ++rp) { if (rp) xcd_barrier(bar);
            pg8::Gemm g{HB, Wt_out, MTOK, 1024, 1024}; S.init(MTOK, 1024, G, bid); EpiRes E{a.in[0], a.in[1], MOD + 2048, a.out};
            pg8::gemm_phase<EpiRes, pg8::StaticOrder>(lds, g, S, E, nullptr);
        }
        SEAM(5);
        if (IN(6)) for (int rp = 0; rp < NREP(6); ++rp) { if (rp) xcd_barrier(bar);
            norm_mod_rows(a, a.out, a.out + (size_t)NCTX * DM, a.in[7], 3072, 4096, HB);
        }
        SEAM(6);
        if (IN(7)) for (int rp = 0; rp < NREP(7); ++rp) { if (rp) xcd_barrier(bar);
            pg8::Gemm g{HB, Wt_fi, MTOK, NIN, 1024}; S.init(MTOK, NIN, G, bid); EpiSwiglu E{ACT};
            pg8::gemm_phase<EpiSwiglu, pg8::StaticOrder>(lds, g, S, E, nullptr);
        }
        SEAM(7);
        if (IN(8)) for (int rp = 0; rp < NREP(8); ++rp) { if (rp) xcd_barrier(bar);
            pg8::Gemm g{ACT, Wt_fo, MTOK, 1024, DFF}; S.init(MTOK, 1024, G, bid); EpiRes E{a.out, a.out + (size_t)NCTX * DM, MOD + 5120, a.out};
            pg8::gemm_phase<EpiRes, pg8::StaticOrder>(lds, g, S, E, nullptr);
        }
        SEAM(8);
        if (IN(9)) for (int rp = 0; rp < NREP(9); ++rp) { if (rp) xcd_barrier(bar);
            const int lane = tid & 63, w = tid >> 6; const float* fg = a.in[27];
            for (int row = bid * 8 + w; row < MTOK; row += G * 8) { float* xr = a.out + (size_t)row * DM;
                f32x4 v[4]; float ss = 0.f;
#pragma unroll
                for (int i = 0; i < 4; ++i) { v[i] = *(const f32x4*)(xr + i * 256 + lane * 4); ss += v[i][0] * v[i][0] + v[i][1] * v[i][1] + v[i][2] * v[i][2] + v[i][3] * v[i][3]; }
                ss = wsum64(ss); const float rstd = rsqrtf(ss * (1.0f / 1024.0f) + 1e-6f);
#pragma unroll
                for (int i = 0; i < 4; ++i) { const f32x4 g = *(const f32x4*)(fg + i * 256 + lane * 4); *(f32x4*)(xr + i * 256 + lane * 4) = v[i] * rstd * g; } }
        }
    }
}

extern "C" void kernel_launch(void* const* d_in, const int* in_sizes, int n_in, void* d_out, int out_size, void* d_ws, size_t ws_size, hipStream_t stream) {
    static int grid = 0;
    if (grid == 0) {
        if (n_in != 28 || in_sizes[0] != NCTX * DM || out_size != MTOK * DM + 2 * 32 * 4 * 16384 || ws_size < WS_END) {
            fprintf(stderr, "kernel_launch: unexpected shapes (n_in %d, in0 %d, out %d, ws %zu); nothing launched\n", n_in, n_in > 0 ? in_sizes[0] : -1, out_size, ws_size); grid = -1; return; }
        int dev = 0, cus = 0, per_cu = 0;
        if (hipGetDevice(&dev) != hipSuccess || hipDeviceGetAttribute(&cus, hipDeviceAttributeMultiprocessorCount, dev) != hipSuccess) { grid = -1; return; }
        if (hipFuncSetAttribute((const void*)mk_fwd, hipFuncAttributeMaxDynamicSharedMemorySize, LDS_BYTES) != hipSuccess) { fprintf(stderr, "kernel_launch: hipFuncSetAttribute failed\n"); grid = -1; return; }
        if (hipOccupancyMaxActiveBlocksPerMultiprocessor(&per_cu, (const void*)mk_fwd, 512, LDS_BYTES) != hipSuccess || per_cu < 1) { fprintf(stderr, "kernel_launch: occupancy query says %d\n", per_cu); per_cu = 1; }
        (void)hipGetLastError();
        grid = cus * 1;
    }
    if (grid < 0) return;
    Args a{};
    for (int i = 0; i < 28; ++i) a.in[i] = (const float*)d_in[i];
    a.out = (float*)d_out; a.ws = (unsigned char*)d_ws;
#if MK_ONE_LAUNCH
    if (hipMemsetAsync(d_ws, 0, 16384, stream) != hipSuccess) { fprintf(stderr, "kernel_launch: memset failed\n"); return; }
    a.ph_lo = 0; a.ph_hi = N_PHASES;
    void* args[] = {&a};
    hipError_t e = hipLaunchCooperativeKernel((const void*)mk_fwd, dim3(grid), dim3(512), args, LDS_BYTES, stream);
    if (e != hipSuccess) fprintf(stderr, "kernel_launch: cooperative launch failed: %s (grid %d)\n", hipGetErrorString(e), grid);
#else
    for (int ph = 0; ph < N_PHASES; ++ph) { a.ph_lo = ph; a.ph_hi = ph + 1;
        hipLaunchKernelGGL(mk_fwd, dim3(grid), dim3(512), LDS_BYTES, stream, a); }
#endif
}
```
